# Optimizing an MI355X kernel written in HIP

```python
import math
import jax, jax.numpy as jnp
from jax import lax
import numpy as np


D_MODEL = 2048
BATCH = 16
SEQ = 2048
DEPTH = 1
DEC_BATCH = 4
DEC_SEQ = 8192
PAST_LEN = 128

N_MEM = 256
A_WIDTH = D_MODEL // 2
A_HALF_DIM = 64
A_HEADS = A_WIDTH // (2 * A_HALF_DIM)
A_VDIM = 2 * A_HALF_DIM
B_WIDTH = D_MODEL // 2
B_DIM = 128
B_HEADS = B_WIDTH // B_DIM
CHUNK = 64
REL_BUCKETS = 32
REL_MAX_DIST = 128
Q_BLOCK = 128
X_HEADS = 4
X_DIM = 128
X_WIDTH = X_HEADS * X_DIM
D_FF = -(-8 * D_MODEL // (3 * 256)) * 256
RMS_EPS = 1e-6
IN_SIZES = (A_WIDTH, A_WIDTH, A_WIDTH, B_WIDTH, B_WIDTH, B_WIDTH, B_WIDTH, B_WIDTH, 2 * D_MODEL)
IN_SPLITS = tuple(int(c) for c in np.cumsum(IN_SIZES)[:-1])
N_IN = int(sum(IN_SIZES))

kernel_name = 'hybrid_diffattn_hgrn2_encoder'


def rmsnorm(x, g, eps=RMS_EPS):
    xf = x.astype(jnp.float32)
    y = xf * lax.rsqrt(jnp.mean(xf * xf, axis=-1, keepdims=True) + eps)
    return (y * g.astype(jnp.float32)).astype(x.dtype)


def rel_bucket(rel):
    nb = REL_BUCKETS // 2
    max_exact = nb // 2
    n = jnp.abs(rel)
    nf = jnp.maximum(n, 1).astype(jnp.float32)
    large = max_exact + (jnp.log(nf / max_exact) / math.log(REL_MAX_DIST / max_exact) * (nb - max_exact)).astype(jnp.int32)
    large = jnp.minimum(large, nb - 1)
    return jnp.where(rel > 0, nb, 0) + jnp.where(n < max_exact, n, large)


def diff_attention(q, k, v, rel_bias, lam, g_subln, lam_init):
    bsz, s_len = q.shape[0], q.shape[1]
    nblk = s_len // Q_BLOCK
    q_blocks = jnp.swapaxes(q.reshape(bsz, nblk, Q_BLOCK, A_HEADS, 2, A_HALF_DIM), 0, 1)
    k_pos = jnp.arange(s_len, dtype=jnp.int32)
    scale = A_HALF_DIM ** -0.5

    def block(args):
        q_blk, start = args
        q_pos = start + jnp.arange(Q_BLOCK, dtype=jnp.int32)
        bias = jnp.transpose(rel_bias[rel_bucket(k_pos[None, :] - q_pos[:, None])], (2, 0, 1)).astype(jnp.float32)
        logits = jnp.einsum('bqhcd,bkhcd->bhcqk', q_blk, k).astype(jnp.float32) * scale + bias[None, :, None]
        p = jax.nn.softmax(logits, axis=-1)
        w = p[:, :, 0] - lam * p[:, :, 1]
        return jnp.einsum('bhqk,bkhe->bqhe', w.astype(v.dtype), v)

    starts = jnp.arange(nblk, dtype=jnp.int32) * Q_BLOCK
    o = lax.map(block, (q_blocks, starts))
    o = jnp.swapaxes(o, 0, 1).reshape(bsz, s_len, A_HEADS, A_VDIM)
    o = rmsnorm(o, g_subln) * (1.0 - lam_init)
    return o.reshape(bsz, s_len, A_WIDTH)


def hgrn_chunk_scan(q, k, v, logf):
    bsz, s_len = q.shape[0], q.shape[1]
    n = s_len // CHUNK
    rs = lambda t: t.reshape(bsz, n, CHUNK, B_HEADS, t.shape[-1])
    q, k, v, logf = rs(q), rs(k), rs(v), rs(logf)
    b = jnp.cumsum(logf, axis=2)
    b_ref = b[:, :, CHUNK // 2 - 1:CHUNK // 2]
    b_last = b[:, :, -1:]
    a = jnp.einsum('bnthd,bnshd->bnhts', q * jnp.exp(b - b_ref), k * jnp.exp(b_ref - b))
    tri = jnp.tril(jnp.ones((CHUNK, CHUNK), dtype=bool))
    a = jnp.where(tri, a, 0.0)
    intra = jnp.einsum('bnhts,bnshv->bnthv', a, v)
    kv = jnp.einsum('bnshd,bnshv->bnhdv', k * jnp.exp(b_last - b), v)
    decay = jnp.exp(b_last[:, :, 0])

    def step(state, xs):
        kv_n, dec_n = xs
        return state * dec_n[..., None] + kv_n, state

    s0 = jnp.zeros((bsz, B_HEADS, B_DIM, v.shape[-1]), jnp.float32)
    _, s_prev = lax.scan(step, s0, (jnp.moveaxis(kv, 1, 0), jnp.moveaxis(decay, 1, 0)))
    s_prev = jnp.moveaxis(s_prev, 0, 1)
    inter = jnp.einsum('bnthd,bnhdv->bnthv', q * jnp.exp(b), s_prev)
    return (intra + inter).reshape(bsz, s_len, B_HEADS, v.shape[-1])


def hgrn2_branch(q_in, z_fwd, z_bwd, v_in, g_in, lb_fwd, lb_bwd, g_norm):
    bsz, s_len = q_in.shape[0], q_in.shape[1]
    heads = lambda t: t.reshape(bsz, s_len, B_HEADS, B_DIM)
    q = heads(q_in.astype(jnp.float32)) * B_DIM ** -0.5
    v = heads(v_in.astype(jnp.float32))

    def gates(z, lb):
        z = z.astype(jnp.float32)
        logf = jnp.log(lb + (1.0 - lb) * jax.nn.sigmoid(z))
        k = (1.0 - lb) * jax.nn.sigmoid(-z)
        return heads(k), heads(logf)

    k_f, logf_f = gates(z_fwd, lb_fwd)
    k_b, logf_b = gates(z_bwd, lb_bwd)
    flip = lambda t: jnp.flip(t, axis=1)
    o = hgrn_chunk_scan(q, k_f, v, logf_f) + flip(hgrn_chunk_scan(flip(q), flip(k_b), flip(v), flip(logf_b)))
    o = rmsnorm(o, g_norm) * jax.nn.silu(heads(g_in.astype(jnp.float32)))
    return o.reshape(bsz, s_len, B_WIDTH).astype(q_in.dtype)


def encoder_layer(x, mem, l, p, lb_all):
    dt = x.dtype
    bsz, s_len = x.shape[0], x.shape[1]
    h = rmsnorm(x, p['g_pre_mix'][l])
    proj = h @ p['w_in'][l]
    qa, ka, va, qb, zf, zb, vb, gb, gate_logits = jnp.split(proj, IN_SPLITS, axis=-1)
    lam_init = 0.8 - 0.6 * math.exp(-0.3 * l)
    lam = (jnp.exp(jnp.sum(p['lam_q1'][l].astype(jnp.float32) * p['lam_k1'][l].astype(jnp.float32)))
           - jnp.exp(jnp.sum(p['lam_q2'][l].astype(jnp.float32) * p['lam_k2'][l].astype(jnp.float32))) + lam_init)
    shp = (bsz, s_len, A_HEADS, 2, A_HALF_DIM)
    ya = diff_attention(qa.reshape(shp), ka.reshape(shp), va.reshape(bsz, s_len, A_HEADS, A_VDIM),
                        p['rel_bias'], lam, p['g_subln'][l], lam_init)
    yb = hgrn2_branch(qb, zf, zb, vb, gb, lb_all[0, l], lb_all[1, l], p['g_hgrn_norm'][l])
    g_a, g_b = jnp.split(jax.nn.sigmoid(gate_logits + p['b_merge'][l]), 2, axis=-1)
    mix = g_a * (ya @ p['w_branch_a'][l]) + g_b * (yb @ p['w_branch_b'][l])
    x = x + rmsnorm(mix @ p['w_out'][l], p['g_post_mix'][l])
    h = rmsnorm(x, p['g_pre_x'][l])
    m = rmsnorm(mem, p['g_mem'][l])
    qx = (h @ p['w_q_x'][l]).reshape(bsz, s_len, X_HEADS, X_DIM)
    kv = (m @ p['w_kv_x'][l]).reshape(bsz, mem.shape[1], 2, X_HEADS, X_DIM)
    logits = jnp.einsum('bqhd,bkhd->bhqk', qx, kv[:, :, 0]).astype(jnp.float32) * X_DIM ** -0.5
    att = jax.nn.softmax(logits, axis=-1).astype(dt)
    ox = jnp.einsum('bhqk,bkhd->bqhd', att, kv[:, :, 1]).reshape(bsz, s_len, X_WIDTH)
    x = x + rmsnorm(ox @ p['w_o_x'][l], p['g_post_x'][l])
    h = rmsnorm(x, p['g_pre_ffn'][l])
    gt, up = jnp.split(h @ p['w_gate_up'][l], 2, axis=-1)
    x = x + rmsnorm((jax.nn.silu(gt) * up) @ p['w_down'][l], p['g_post_ffn'][l])
    return x


def trunk(x, mem, p):
    lb_all = jnp.cumsum(jax.nn.softmax(p['hgrn_lb_logits'].astype(jnp.float32), axis=1), axis=1)
    for l in range(DEPTH):
        x = encoder_layer(x, mem, l, p, lb_all)
    return x


def setup_inputs(seed: int = 0) -> dict:
    key = jax.random.key(seed)
    ks = iter(jax.random.split(key, 40))
    nrm = lambda shape, scale: jax.random.normal(next(ks), shape, jnp.float32) * scale
    gain = lambda shape: 1.0 + nrm(shape, 0.05)
    return {
        'x_prompt': nrm((BATCH, SEQ, D_MODEL), 1.0),
        'x_sample': nrm((DEC_BATCH, DEC_SEQ, D_MODEL), 1.0),
        'mem_prompt': nrm((BATCH, N_MEM, D_MODEL), 1.0),
        'mem_sample': nrm((DEC_BATCH, N_MEM, D_MODEL), 1.0),
        'rel_bias': nrm((REL_BUCKETS, A_HEADS), 0.5),
        'hgrn_lb_logits': nrm((2, DEPTH + 1, B_WIDTH), 0.1),
        'g_pre_mix': gain((DEPTH, D_MODEL)),
        'w_in': nrm((DEPTH, D_MODEL, N_IN), D_MODEL ** -0.5),
        'b_merge': nrm((DEPTH, 2 * D_MODEL), 0.1),
        'lam_q1': nrm((DEPTH, A_HALF_DIM), 0.1),
        'lam_k1': nrm((DEPTH, A_HALF_DIM), 0.1),
        'lam_q2': nrm((DEPTH, A_HALF_DIM), 0.1),
        'lam_k2': nrm((DEPTH, A_HALF_DIM), 0.1),
        'g_subln': gain((DEPTH, A_VDIM)),
        'g_hgrn_norm': gain((DEPTH, B_DIM)),
        'w_branch_a': nrm((DEPTH, A_WIDTH, D_MODEL), A_WIDTH ** -0.5),
        'w_branch_b': nrm((DEPTH, B_WIDTH, D_MODEL), B_WIDTH ** -0.5),
        'w_out': nrm((DEPTH, D_MODEL, D_MODEL), D_MODEL ** -0.5),
        'g_post_mix': gain((DEPTH, D_MODEL)),
        'g_pre_x': gain((DEPTH, D_MODEL)),
        'g_mem': gain((DEPTH, D_MODEL)),
        'w_q_x': nrm((DEPTH, D_MODEL, X_WIDTH), D_MODEL ** -0.5),
        'w_kv_x': nrm((DEPTH, D_MODEL, 2 * X_WIDTH), D_MODEL ** -0.5),
        'w_o_x': nrm((DEPTH, X_WIDTH, D_MODEL), X_WIDTH ** -0.5),
        'g_post_x': gain((DEPTH, D_MODEL)),
        'g_pre_ffn': gain((DEPTH, D_MODEL)),
        'w_gate_up': nrm((DEPTH, D_MODEL, 2 * D_FF), D_MODEL ** -0.5),
        'w_down': nrm((DEPTH, D_FF, D_MODEL), D_FF ** -0.5),
        'g_post_ffn': gain((DEPTH, D_MODEL)),
    }


def reference(x_prompt, x_sample, mem_prompt, mem_sample, rel_bias, hgrn_lb_logits, g_pre_mix, w_in, b_merge,
              lam_q1, lam_k1, lam_q2, lam_k2, g_subln, g_hgrn_norm, w_branch_a, w_branch_b, w_out, g_post_mix,
              g_pre_x, g_mem, w_q_x, w_kv_x, w_o_x, g_post_x, g_pre_ffn, w_gate_up, w_down, g_post_ffn):
    p = dict(rel_bias=rel_bias, hgrn_lb_logits=hgrn_lb_logits, g_pre_mix=g_pre_mix, w_in=w_in, b_merge=b_merge,
             lam_q1=lam_q1, lam_k1=lam_k1, lam_q2=lam_q2, lam_k2=lam_k2, g_subln=g_subln,
             g_hgrn_norm=g_hgrn_norm, w_branch_a=w_branch_a, w_branch_b=w_branch_b, w_out=w_out,
             g_post_mix=g_post_mix, g_pre_x=g_pre_x, g_mem=g_mem, w_q_x=w_q_x, w_kv_x=w_kv_x, w_o_x=w_o_x,
             g_post_x=g_post_x, g_pre_ffn=g_pre_ffn, w_gate_up=w_gate_up, w_down=w_down, g_post_ffn=g_post_ffn)
    y_prompt = trunk(x_prompt, mem_prompt, p)
    y_sample = trunk(x_sample, mem_sample, p)
    return (y_prompt, y_sample)
```

```cpp
#include <hip/hip_runtime.h>
#include <hip/hip_cooperative_groups.h>
#include <cstdio>
#include <cstdint>
namespace cg = cooperative_groups;

#ifndef MK_COOP
#define MK_COOP 1
#endif

#define LAS __attribute__((address_space(3)))
#define DI __device__ __forceinline__
typedef unsigned short bf16_t;
typedef short bf16x8 __attribute__((ext_vector_type(8)));
typedef short s16x4 __attribute__((ext_vector_type(4)));
typedef float f32x4 __attribute__((ext_vector_type(4)));
typedef float f32x2 __attribute__((ext_vector_type(2)));
typedef float f32x16 __attribute__((ext_vector_type(16)));
typedef unsigned u32x4 __attribute__((ext_vector_type(4)));
typedef unsigned u32x2 __attribute__((ext_vector_type(2)));

constexpr int DM = 2048, NPROJ = 10240, DFF = 5632;
constexpr int GR = 16384;
constexpr int NGROUP = 4;
constexpr int NMEMROWS = 5120;
constexpr float EPS = 1e-6f;
constexpr float LOG2E = 1.4426950408889634f;
constexpr int LDS_BYTES = 143360;
constexpr int NPH = 14;
constexpr int NSTEPS = 1 + NGROUP * NPH;

constexpr size_t WS_WIN = 0;
constexpr size_t WS_WA = WS_WIN + (size_t)12288 * 2048 * 2;
constexpr size_t WS_WB = WS_WA + (size_t)2048 * 1024 * 2;
constexpr size_t WS_WOUT = WS_WB + (size_t)2048 * 1024 * 2;
constexpr size_t WS_WQ = WS_WOUT + (size_t)2048 * 2048 * 2;
constexpr size_t WS_WKV = WS_WQ + (size_t)512 * 2048 * 2;
constexpr size_t WS_WO = WS_WKV + (size_t)1024 * 2048 * 2;
constexpr size_t WS_WGU = WS_WO + (size_t)2048 * 512 * 2;
constexpr size_t WS_WD = WS_WGU + (size_t)11264 * 2048 * 2;
constexpr size_t WS_MN = WS_WD + (size_t)2048 * 5632 * 2;
constexpr size_t WS_KX = WS_MN + (size_t)NMEMROWS * 2048 * 2;
constexpr size_t WS_VXT = WS_KX + (size_t)NMEMROWS * 512 * 2;
constexpr size_t WS_CTR = WS_VXT + (size_t)NMEMROWS * 512 * 2;
constexpr size_t WS_H = WS_CTR + 4096;
constexpr size_t WS_PROJ = WS_H + (size_t)GR * 2048 * 2;
constexpr size_t WS_VT = WS_PROJ + (size_t)GR * NPROJ * 2;
constexpr size_t WS_YA = WS_VT + (size_t)2048 * GR * 2;
constexpr size_t WS_YB = WS_YA + (size_t)GR * 1024 * 2;
constexpr size_t WS_OF = WS_YB + (size_t)GR * 1024 * 2;
constexpr size_t WS_OB = WS_OF + (size_t)GR * 1024 * 2;
constexpr size_t WS_Y = WS_OB + (size_t)GR * 1024 * 2;
constexpr size_t WS_END = WS_Y + (size_t)GR * 2048 * 2;

struct Params {
    const float* in[29];
    float* out;
    unsigned char* ws;
    int lo, hi;
};

DI float bf2f(bf16_t b) { return __uint_as_float(((unsigned)b) << 16); }
DI float bflo(unsigned u) { return __uint_as_float(u << 16); }
DI float bfhi(unsigned u) { return __uint_as_float(u & 0xffff0000u); }
typedef __bf16 bfx2_t __attribute__((ext_vector_type(2)));
DI unsigned pk2(float lo, float hi) { const f32x2 v = {lo, hi}; const bfx2_t b = __builtin_convertvector(v, bfx2_t); return __builtin_bit_cast(unsigned, b); }
DI float fexp2(float x) { return __builtin_amdgcn_exp2f(x); }
DI float fexp(float x) { return __builtin_amdgcn_exp2f(x * LOG2E); }
DI float frcp(float x) { return __builtin_amdgcn_rcpf(x); }
DI float sigmoidf_(float x) { return frcp(1.f + fexp(-x)); }
DI float siluf_(float x) { return x * frcp(1.f + fexp(-x)); }
DI float wave_sum(float v) {
#pragma unroll
    for (int o = 1; o < 64; o <<= 1) v += __shfl_xor(v, o);
    return v;
}
DI int otid() { int t = threadIdx.x; asm volatile("" : "+v"(t)); return t; }
#define MFMA16(a, b, c) __builtin_amdgcn_mfma_f32_16x16x32_bf16((a), (b), (c), 0, 0, 0)
#define MFMA32(a, b, c) __builtin_amdgcn_mfma_f32_32x32x16_bf16((a), (b), (c), 0, 0, 0)

namespace pg8 {
constexpr int BM = 256, BK = 64, HALF = 128, HTB = HALF * BK * 2, STAGE_BYTES = 8 * HTB, NXCD = 8, WGM = 8;
__host__ __device__ __forceinline__ int lds_byte(int r, int c) { const int st = (r >> 4) * 2 + (c >> 5), rr = r & 15, cc = c & 31, ob = rr * 64 + cc * 2; return st * 1024 + (ob ^ (((ob >> 9) & 1) << 5)); }
__host__ __device__ __forceinline__ void stage_rc(int b, int& R, int& C) { const int st = b / 1024, sb = b % 1024, swz = sb ^ (((sb >> 9) & 1) << 5); R = (st >> 1) * 16 + swz / 64; C = (st & 1) * 32 + (swz % 64) / 2; }
__host__ __device__ __forceinline__ int perm32(int rho) { const int n = rho >> 4, i = rho & 15; return 8 * (i >> 2) + 4 * n + (i & 3); }
struct Unit { int pm, pn; };
struct Gemm { const bf16_t* A; const bf16_t* Bt; int M, N, K; };
struct StaticOrder {
    int nM, nN, nwg, G, c;
    __device__ void init(int M, int N, int G_, int c_) { nM = M / BM; nN = N / BM; nwg = nM * nN; G = G_; c = c_; }
    __device__ bool next(int i, Unit& u) const {
        const long L = (long)i * G + c; if (L >= nwg) return false;
        int wgid = (int)L; { const int q = nwg / NXCD, r = nwg % NXCD, xcd = wgid % NXCD, off = wgid / NXCD; wgid = (xcd < r ? xcd * (q + 1) : r * (q + 1) + (xcd - r) * q) + off; }
        const int nig = WGM * nN, gid = wgid / nig, fm = gid * WGM, gsz = (nM - fm) < WGM ? (nM - fm) : WGM;
        u.pm = fm + ((wgid % nig) % gsz); u.pn = (wgid % nig) / gsz; return true;
    }
};

template <class Epi>
__device__ __forceinline__ void gemm_phase(LAS unsigned char* lds, const Gemm g, const StaticOrder& S, const Epi& E) {
    const int tid = otid(), wid = __builtin_amdgcn_readfirstlane(tid >> 6), lane = tid & 63, wr = wid >> 2, wc = wid & 3, fr = lane & 15, fq = lane >> 4;
    const int K = g.K, nt = K / BK;
    unsigned voffA[2], voffB[2];
#pragma unroll
    for (int i = 0; i < 2; ++i) { int R, C; stage_rc(tid * 16 + i * 8192, R, C); const int Rb = (R & ~31) + perm32(R & 31);
        voffA[i] = (unsigned)(R * K + C) * 2u; voffB[i] = (unsigned)(Rb * K + C) * 2u; }
    const size_t kstep = (size_t)(BK * 2);
    const size_t hstep = (size_t)HALF * K * 2;
    const size_t tstep = 2 * hstep;
    const unsigned ldsw = (unsigned)wid * 1024u;
    const int aoff = lds_byte(wr * 64 + fr, fq * 8), boff = lds_byte(wc * 32 + fr, fq * 8);
#define PG8_SA(b, h) (((b) * 2 + (h)) * HTB)
#define PG8_SB(b, h) ((4 + (b) * 2 + (h)) * HTB)
#define PG8_STAGE(bufoff, gbase, voff) do { _Pragma("unroll") for (int _i = 0; _i < 2; ++_i) \
        __builtin_amdgcn_global_load_lds((const unsigned*)((const char*)(gbase) + (voff)[_i]), (LAS unsigned*)(lds + (bufoff) + ldsw + _i * 8192), 16, 0, 0); } while (0)
#define PG8_LDA(dst, b, h) do { _Pragma("unroll") for (int m = 0; m < 4; ++m) _Pragma("unroll") for (int k = 0; k < 2; ++k) dst[m][k] = *(const LAS bf16x8*)(lds + PG8_SA(b, h) + aoff + m * 2048 + k * 1024); } while (0)
#define PG8_LDB(dst, b, h) do { _Pragma("unroll") for (int n = 0; n < 2; ++n) _Pragma("unroll") for (int k = 0; k < 2; ++k) dst[n][k] = *(const LAS bf16x8*)(lds + PG8_SB(b, h) + boff + n * 2048 + k * 1024); } while (0)
#define PG8_MMA(ai, bj, At, Bt) do { __builtin_amdgcn_s_setprio(1); _Pragma("unroll") for (int m = 0; m < 4; ++m) _Pragma("unroll") for (int n = 0; n < 2; ++n) _Pragma("unroll") for (int k = 0; k < 2; ++k) \
        acc[ai][bj][m][n] = __builtin_amdgcn_mfma_f32_16x16x32_bf16(Bt[n][k], At[m][k], acc[ai][bj][m][n], 0, 0, 0); __builtin_amdgcn_s_setprio(0); } while (0)
#define PG8_WAIT_V(n) asm volatile("s_waitcnt vmcnt(" #n ")" ::: "memory")
#define PG8_WAIT_L(n) asm volatile("s_waitcnt lgkmcnt(" #n ")" ::: "memory")
#define PG8_BAR __builtin_amdgcn_s_barrier()
#define PG8_SCHED __builtin_amdgcn_sched_barrier(0)
    Unit cur, nxt; int ui = 0;
    if (!S.next(0, cur)) return;
    f32x4 acc[2][2][4][2];
#pragma unroll
    for (int a = 0; a < 2; ++a)
#pragma unroll
        for (int b = 0; b < 2; ++b)
#pragma unroll
            for (int m = 0; m < 4; ++m)
#pragma unroll
                for (int n = 0; n < 2; ++n) acc[a][b][m][n] = (f32x4){0.f, 0.f, 0.f, 0.f};
    bf16x8 At[4][2], B0[2][2], B1[2][2];
    const char* cA = (const char*)g.A + (size_t)cur.pm * tstep; const char* cB = (const char*)g.Bt + (size_t)cur.pn * tstep;
    PG8_STAGE(PG8_SB(0, 0), cB, voffB); PG8_STAGE(PG8_SA(0, 0), cA, voffA); PG8_STAGE(PG8_SB(0, 1), cB + hstep, voffB); PG8_STAGE(PG8_SA(0, 1), cA + hstep, voffA);
    if (wr == 1) PG8_BAR;
    PG8_WAIT_V(4); PG8_BAR;
    PG8_STAGE(PG8_SB(1, 0), cB + kstep, voffB); PG8_STAGE(PG8_SA(1, 0), cA + kstep, voffA); PG8_STAGE(PG8_SB(1, 1), cB + hstep + kstep, voffB);
    PG8_WAIT_V(6); PG8_BAR;
    for (;;) {
        const bool has_next = S.next(ui + 1, nxt);
        const char* nA = has_next ? (const char*)g.A + (size_t)nxt.pm * tstep : cA; const char* nB = has_next ? (const char*)g.Bt + (size_t)nxt.pn * tstep : cB;
        for (int t = 0; t < nt; t += 2) {
            const bool last = (t == nt - 2);
            const char* a1 = cA + (size_t)(t + 1) * kstep;
            const char* a2 = last ? nA : cA + (size_t)(t + 2) * kstep; const char* b2 = last ? nB : cB + (size_t)(t + 2) * kstep;
            const char* a3 = a2 + kstep; const char* b3 = b2 + kstep;
            PG8_LDB(B0, 0, 0); PG8_SCHED; PG8_LDA(At, 0, 0); PG8_STAGE(PG8_SA(1, 1), a1 + hstep, voffA);
            PG8_WAIT_L(8); PG8_BAR; PG8_WAIT_L(0); PG8_MMA(0, 0, At, B0); PG8_BAR; PG8_SCHED;
            PG8_LDB(B1, 0, 1); PG8_STAGE(PG8_SB(0, 0), b2, voffB);
            PG8_BAR; PG8_WAIT_L(0); PG8_MMA(0, 1, At, B1); PG8_BAR;
            PG8_LDA(At, 0, 1); PG8_STAGE(PG8_SA(0, 0), a2, voffA);
            PG8_BAR; PG8_WAIT_L(0); PG8_MMA(1, 0, At, B0); PG8_BAR; PG8_SCHED;
            PG8_STAGE(PG8_SB(0, 1), b2 + hstep, voffB);
            PG8_WAIT_V(6); PG8_BAR; PG8_MMA(1, 1, At, B1); PG8_BAR;
            PG8_LDB(B0, 1, 0); PG8_SCHED; PG8_LDA(At, 1, 0); PG8_STAGE(PG8_SA(0, 1), a2 + hstep, voffA);
            PG8_WAIT_L(8); PG8_BAR; PG8_WAIT_L(0); PG8_MMA(0, 0, At, B0); PG8_BAR; PG8_SCHED;
            PG8_LDB(B1, 1, 1); PG8_STAGE(PG8_SB(1, 0), b3, voffB);
            PG8_BAR; PG8_WAIT_L(0); PG8_MMA(0, 1, At, B1); PG8_BAR;
            PG8_LDA(At, 1, 1); PG8_STAGE(PG8_SA(1, 0), a3, voffA);
            PG8_BAR; PG8_WAIT_L(0); PG8_MMA(1, 0, At, B0); PG8_BAR; PG8_SCHED;
            PG8_STAGE(PG8_SB(1, 1), b3 + hstep, voffB);
            PG8_WAIT_V(6); PG8_BAR; PG8_MMA(1, 1, At, B1); PG8_BAR;
        }
        E(acc, cur, wr, wc, fr, fq);
        if (!has_next) break;
#pragma unroll
        for (int a = 0; a < 2; ++a)
#pragma unroll
            for (int b = 0; b < 2; ++b)
#pragma unroll
                for (int m = 0; m < 4; ++m)
#pragma unroll
                    for (int n = 0; n < 2; ++n) acc[a][b][m][n] = (f32x4){0.f, 0.f, 0.f, 0.f};
        cur = nxt; cA = nA; cB = nB; ++ui;
    }
    PG8_WAIT_V(0);
    if (wr == 0) PG8_BAR;
    PG8_BAR;
#undef PG8_SA
#undef PG8_SB
#undef PG8_STAGE
#undef PG8_LDA
#undef PG8_LDB
#undef PG8_MMA
#undef PG8_WAIT_V
#undef PG8_WAIT_L
#undef PG8_BAR
#undef PG8_SCHED
}

template <int MODE> struct EpiBf16 {
    bf16_t* O; int ldc; const float* bias;
    DI void operator()(const f32x4 (&acc)[2][2][4][2], const Unit& u, int wr, int wc, int fr, int fq) const {
        const int row0 = u.pm * BM + wr * 64 + fr, col0 = u.pn * BM + wc * 32 + 8 * fq;
        const bool gate = (MODE == 1) && (u.pn >= 24);
        f32x4 bv[2][2];
#pragma unroll
        for (int bj = 0; bj < 2; ++bj)
#pragma unroll
            for (int n = 0; n < 2; ++n) bv[bj][n] = gate ? *(const f32x4*)(bias + (col0 - 6144) + bj * HALF + 4 * n) : (f32x4){0.f, 0.f, 0.f, 0.f};
#pragma unroll
        for (int ai = 0; ai < 2; ++ai)
#pragma unroll
            for (int m = 0; m < 4; ++m) { bf16_t* rowp = O + (size_t)(row0 + ai * HALF + m * 16) * ldc + col0;
#pragma unroll
                for (int bj = 0; bj < 2; ++bj) { f32x4 v0 = acc[ai][bj][m][0], v1 = acc[ai][bj][m][1];
                    if (gate) {
#pragma unroll
                        for (int j = 0; j < 4; ++j) { v0[j] = sigmoidf_(v0[j] + bv[bj][0][j]); v1[j] = sigmoidf_(v1[j] + bv[bj][1][j]); } }
                    u32x4 w; w.x = pk2(v0[0], v0[1]); w.y = pk2(v0[2], v0[3]); w.z = pk2(v1[0], v1[1]); w.w = pk2(v1[2], v1[3]);
                    *(u32x4*)(rowp + bj * HALF) = w; } }
    }
};
template <bool ACCUM> struct EpiGate {
    bf16_t* O; int ldc; const bf16_t* Gt; int ldg;
    DI void operator()(const f32x4 (&acc)[2][2][4][2], const Unit& u, int wr, int wc, int fr, int fq) const {
        const int row0 = u.pm * BM + wr * 64 + fr, col0 = u.pn * BM + wc * 32 + 8 * fq;
#pragma unroll
        for (int ai = 0; ai < 2; ++ai)
#pragma unroll
            for (int m = 0; m < 4; ++m) { const size_t row = (size_t)(row0 + ai * HALF + m * 16);
#pragma unroll
                for (int bj = 0; bj < 2; ++bj) {
                    const u32x4 gv = *(const u32x4*)(Gt + row * ldg + col0 + bj * HALF);
                    bf16_t* op = O + row * ldc + col0 + bj * HALF;
                    f32x4 v0 = acc[ai][bj][m][0], v1 = acc[ai][bj][m][1];
                    v0[0] *= bflo(gv.x); v0[1] *= bfhi(gv.x); v0[2] *= bflo(gv.y); v0[3] *= bfhi(gv.y);
                    v1[0] *= bflo(gv.z); v1[1] *= bfhi(gv.z); v1[2] *= bflo(gv.w); v1[3] *= bfhi(gv.w);
                    if (ACCUM) { const u32x4 pv = *(const u32x4*)op;
                        v0[0] += bflo(pv.x); v0[1] += bfhi(pv.x); v0[2] += bflo(pv.y); v0[3] += bfhi(pv.y);
                        v1[0] += bflo(pv.z); v1[1] += bfhi(pv.z); v1[2] += bflo(pv.w); v1[3] += bfhi(pv.w); }
                    u32x4 w; w.x = pk2(v0[0], v0[1]); w.y = pk2(v0[2], v0[3]); w.z = pk2(v1[0], v1[1]); w.w = pk2(v1[2], v1[3]);
                    *(u32x4*)op = w; } }
    }
};
struct EpiSwiGLU {
    bf16_t* O; int ldc;
    DI void operator()(const f32x4 (&acc)[2][2][4][2], const Unit& u, int wr, int wc, int fr, int fq) const {
        const int row0 = u.pm * BM + wr * 64 + fr, col0 = u.pn * HALF + wc * 32 + 8 * fq;
#pragma unroll
        for (int ai = 0; ai < 2; ++ai)
#pragma unroll
            for (int m = 0; m < 4; ++m) { bf16_t* op = O + (size_t)(row0 + ai * HALF + m * 16) * ldc + col0;
                f32x4 v0, v1;
#pragma unroll
                for (int j = 0; j < 4; ++j) { v0[j] = siluf_(acc[ai][0][m][0][j]) * acc[ai][1][m][0][j]; v1[j] = siluf_(acc[ai][0][m][1][j]) * acc[ai][1][m][1][j]; }
                u32x4 w; w.x = pk2(v0[0], v0[1]); w.y = pk2(v0[2], v0[3]); w.z = pk2(v1[0], v1[1]); w.w = pk2(v1[2], v1[3]);
                *(u32x4*)op = w; }
    }
};
}

template <class Epi>
DI void run_gemm(LAS unsigned char* lds, const bf16_t* A, const bf16_t* Bt, int M, int N, int K, const Epi& E, int cshift = 0) {
    pg8::Gemm g; g.A = A; g.Bt = Bt; g.M = M; g.N = N; g.K = K;
    pg8::StaticOrder S; S.init(M, N, (int)gridDim.x, (int)((blockIdx.x + cshift) % gridDim.x));
    pg8::gemm_phase<Epi>(lds, g, S, E);
}

DI int rowmap(int mode, int n) {
    if (mode == 0) return n;
    if (mode == 1) {
        if (n < 2048) return n;
        if (n < 3072) return 10240 + (n - 2048);
        if (n < 6144) return n - 1024;
        if (n < 7168) return 11264 + (n - 6144);
        if (n < 8192) return 5120 + (n - 7168);
        return 6144 + (n - 8192);
    }
    const int up = n >= DFF, j = up ? n - DFF : n;
    return 256 * (j >> 7) + (up ? 128 : 0) + (j & 127);
}
DI void transpose_tile(const float* __restrict__ W, int K, int N, bf16_t* __restrict__ WT, int mode, int tile, LAS unsigned char* lds) {
    const int tid = otid();
    const int nb = N >> 6, kb = tile / nb, nbk = tile - kb * nb, k0 = kb << 6, n0 = nbk << 6;
    LAS bf16_t* T = (LAS bf16_t*)lds;
    const int r = tid >> 4, c4 = (tid & 15) * 4;
#pragma unroll
    for (int i = 0; i < 2; ++i) { const int kk = r + 32 * i;
        const f32x4 v = *(const f32x4*)(W + (size_t)(k0 + kk) * N + n0 + c4);
        const unsigned p0 = pk2(v[0], v[1]), p1 = pk2(v[2], v[3]);
        T[(c4 + 0) * 72 + kk] = (bf16_t)(p0 & 0xffffu); T[(c4 + 1) * 72 + kk] = (bf16_t)(p0 >> 16);
        T[(c4 + 2) * 72 + kk] = (bf16_t)(p1 & 0xffffu); T[(c4 + 3) * 72 + kk] = (bf16_t)(p1 >> 16); }
    __syncthreads();
    { const int n = tid >> 3, part = tid & 7;
      const u32x4 o = *(const LAS u32x4*)(lds + n * 144 + part * 16);
      const int row = rowmap(mode, n0 + n);
      *(u32x4*)(WT + (size_t)row * K + k0 + part * 8) = o; }
    __syncthreads();
}

DI void rowpass(const float* xin, const bf16_t* __restrict__ y, const float* __restrict__ gpost, float* xout,
                const float* __restrict__ gpre, bf16_t* __restrict__ hout, int nrows) {
    const int tid_ = otid(); const int lane = tid_ & 63, gw = blockIdx.x * 8 + (tid_ >> 6), ngw = gridDim.x * 8;
    for (int r = gw; r < nrows; r += ngw) {
        const float* xr = xin + (size_t)r * DM + lane * 4;
        f32x4 xv[8];
#pragma unroll
        for (int j = 0; j < 8; ++j) xv[j] = *(const f32x4*)(xr + j * 256);
        if (y) {
            const bf16_t* yr = y + (size_t)r * DM + lane * 4;
            f32x4 yv[8]; float ss = 0.f;
#pragma unroll
            for (int j = 0; j < 8; ++j) { const u32x2 u = *(const u32x2*)(yr + j * 256); yv[j] = (f32x4){bflo(u.x), bfhi(u.x), bflo(u.y), bfhi(u.y)};
                ss += yv[j][0] * yv[j][0] + yv[j][1] * yv[j][1] + yv[j][2] * yv[j][2] + yv[j][3] * yv[j][3]; }
            ss = wave_sum(ss);
            const float r1 = rsqrtf(ss * (1.f / DM) + EPS);
#pragma unroll
            for (int j = 0; j < 8; ++j) { const f32x4 gg = *(const f32x4*)(gpost + j * 256 + lane * 4); xv[j] += yv[j] * r1 * gg; }
        }
        if (xout) {
            float* xo = xout + (size_t)r * DM + lane * 4;
#pragma unroll
            for (int j = 0; j < 8; ++j) *(f32x4*)(xo + j * 256) = xv[j];
        }
        if (hout) {
            float ss = 0.f;
#pragma unroll
            for (int j = 0; j < 8; ++j) ss += xv[j][0] * xv[j][0] + xv[j][1] * xv[j][1] + xv[j][2] * xv[j][2] + xv[j][3] * xv[j][3];
            ss = wave_sum(ss);
            const float r2 = rsqrtf(ss * (1.f / DM) + EPS);
            bf16_t* ho = hout + (size_t)r * DM + lane * 4;
#pragma unroll
            for (int j = 0; j < 8; ++j) { const f32x4 gg = *(const f32x4*)(gpre + j * 256 + lane * 4); const f32x4 hv = xv[j] * r2 * gg;
                u32x2 w; w.x = pk2(hv[0], hv[1]); w.y = pk2(hv[2], hv[3]); *(u32x2*)(ho + j * 256) = w; }
        }
    }
}

DI void hgrn_combine(const bf16_t* __restrict__ OF, const bf16_t* __restrict__ OB, const bf16_t* __restrict__ PROJ, const float* __restrict__ gn, bf16_t* __restrict__ YB, int nrows) {
    const int tid_ = otid(); const int lane = tid_ & 63, gw = blockIdx.x * 8 + (tid_ >> 6), ngw = gridDim.x * 8;
    for (int r = gw; r < nrows; r += ngw) {
        float o[16]; float ss = 0.f;
#pragma unroll
        for (int hlf = 0; hlf < 2; ++hlf) {
            const u32x4 a = *(const u32x4*)(OF + (size_t)r * 1024 + lane * 16 + hlf * 8);
            const u32x4 b = *(const u32x4*)(OB + (size_t)r * 1024 + lane * 16 + hlf * 8);
#pragma unroll
            for (int k = 0; k < 4; ++k) { o[hlf * 8 + 2 * k] = bflo(a[k]) + bflo(b[k]); o[hlf * 8 + 2 * k + 1] = bfhi(a[k]) + bfhi(b[k]); }
        }
#pragma unroll
        for (int k = 0; k < 16; ++k) ss += o[k] * o[k];
        ss += __shfl_xor(ss, 1); ss += __shfl_xor(ss, 2); ss += __shfl_xor(ss, 4);
        const float rr = rsqrtf(ss * (1.f / 128.f) + EPS);
#pragma unroll
        for (int hlf = 0; hlf < 2; ++hlf) {
            const u32x4 gbv = *(const u32x4*)(PROJ + (size_t)r * NPROJ + 5120 + lane * 16 + hlf * 8);
            const f32x4 g0 = *(const f32x4*)(gn + (lane & 7) * 16 + hlf * 8), g1 = *(const f32x4*)(gn + (lane & 7) * 16 + hlf * 8 + 4);
            float v[8];
#pragma unroll
            for (int k = 0; k < 4; ++k) { v[2 * k] = siluf_(bflo(gbv[k])); v[2 * k + 1] = siluf_(bfhi(gbv[k])); }
            u32x4 w;
            w.x = pk2(o[hlf * 8 + 0] * rr * g0[0] * v[0], o[hlf * 8 + 1] * rr * g0[1] * v[1]);
            w.y = pk2(o[hlf * 8 + 2] * rr * g0[2] * v[2], o[hlf * 8 + 3] * rr * g0[3] * v[3]);
            w.z = pk2(o[hlf * 8 + 4] * rr * g1[0] * v[4], o[hlf * 8 + 5] * rr * g1[1] * v[5]);
            w.w = pk2(o[hlf * 8 + 6] * rr * g1[2] * v[6], o[hlf * 8 + 7] * rr * g1[3] * v[7]);
            *(u32x4*)(YB + (size_t)r * 1024 + lane * 16 + hlf * 8) = w;
        }
    }
}

constexpr int AT_KB = 64 * 272, AT_VB = 128 * 136;
constexpr int AT_K0 = 0, AT_V0 = 2 * AT_KB, AT_TAB = 2 * AT_KB + 2 * AT_VB, AT_EX = AT_TAB + 2048;
template <int KSTEPS, bool DIFF>
DI void attn_unit(LAS unsigned char* lds, const bf16_t* __restrict__ Q, int ldq, const bf16_t* __restrict__ Kg, int ldk,
                  const bf16_t* __restrict__ VT, size_t ldvt, int nkeys, int qpos0, const float* __restrict__ relb, float lam,
                  const float* __restrict__ gsub, bf16_t* __restrict__ O, int ldo, float c1) {
    const int tid = otid(), wid = tid >> 6, lane = tid & 63, ql = lane & 31, h = lane >> 5;
    const int c = DIFF ? (wid >> 2) : 0;
    const int qrow0 = DIFF ? (wid & 3) * 32 : wid * 32;
    LAS float* tab = (LAS float*)(lds + AT_TAB);
    if (DIFF) {
        if (tid < 257) { const int rel = tid - 128; const int n = rel < 0 ? -rel : rel;
            int b;
            if (n < 8) b = n; else { b = 8 + (int)(__logf((float)n * 0.125f) * (8.f / 2.772588722239781f) + 1e-4f); b = b > 15 ? 15 : b; }
            if (rel > 0) b += 16;
            tab[tid] = relb[b * 8] * LOG2E; }
    }
    bf16x8 qf[KSTEPS];
    { const bf16_t* qp = Q + (size_t)(qrow0 + ql) * ldq + c * 64 + h * 8;
#pragma unroll
      for (int ks = 0; ks < KSTEPS; ++ks) qf[ks] = *(const bf16x8*)(qp + ks * 16); }
    const int kkey0 = tid >> 4, kpart = tid & 15;
    const int ve0 = tid >> 3, vpart = tid & 7;
    u32x4 kreg[2], vreg[2];
    const bf16_t* kgp = Kg + (size_t)kkey0 * ldk + kpart * 8;
    const bf16_t* vgp = VT + (size_t)ve0 * ldvt + vpart * 8;
#define AT_LOAD(kt) do { kreg[0] = *(const u32x4*)(kgp + (size_t)((kt) * 64) * ldk); kreg[1] = *(const u32x4*)(kgp + (size_t)((kt) * 64 + 32) * ldk); \
        vreg[0] = *(const u32x4*)(vgp + (kt) * 64); vreg[1] = *(const u32x4*)(vgp + (size_t)64 * ldvt + (kt) * 64); } while (0)
#define AT_STORE(buf) do { *(LAS u32x4*)(lds + AT_K0 + (buf) * AT_KB + kkey0 * 272 + kpart * 16) = kreg[0]; *(LAS u32x4*)(lds + AT_K0 + (buf) * AT_KB + (kkey0 + 32) * 272 + kpart * 16) = kreg[1]; \
        *(LAS u32x2*)(lds + AT_V0 + (buf) * AT_VB + ve0 * 136 + vpart * 16) = (u32x2){vreg[0].x, vreg[0].y}; *(LAS u32x2*)(lds + AT_V0 + (buf) * AT_VB + ve0 * 136 + vpart * 16 + 8) = (u32x2){vreg[0].z, vreg[0].w}; \
        *(LAS u32x2*)(lds + AT_V0 + (buf) * AT_VB + (ve0 + 64) * 136 + vpart * 16) = (u32x2){vreg[1].x, vreg[1].y}; *(LAS u32x2*)(lds + AT_V0 + (buf) * AT_VB + (ve0 + 64) * 136 + vpart * 16 + 8) = (u32x2){vreg[1].z, vreg[1].w}; } while (0)
    AT_LOAD(0); AT_STORE(0);
    __syncthreads();
    const int nt = nkeys >> 6;
    f32x16 o[4];
#pragma unroll
    for (int et = 0; et < 4; ++et)
#pragma unroll
        for (int i = 0; i < 16; ++i) o[et][i] = 0.f;
    float m = -1e30f, l = 0.f, mthr = -1e30f;
    const int qpos = qpos0 + qrow0 + ql;
    for (int kt = 0; kt < nt; ++kt) {
        const int cur = kt & 1;
        if (DIFF) { if (kt + 1 < nt) AT_LOAD(kt + 1); }
        f32x16 s[2];
#pragma unroll
        for (int kt2 = 0; kt2 < 2; ++kt2) {
#pragma unroll
            for (int i = 0; i < 16; ++i) s[kt2][i] = 0.f;
#pragma unroll
            for (int ks = 0; ks < KSTEPS; ++ks) {
                const bf16x8 a = *(const LAS bf16x8*)(lds + AT_K0 + cur * AT_KB + (kt2 * 32 + ql) * 272 + (c * 64 + ks * 16 + h * 8) * 2);
                s[kt2] = MFMA32(a, qf[ks], s[kt2]);
            }
        }
        if (DIFF) {
            const int kbase = kt * 64;
            const int relmin = kbase - (qpos0 + qrow0 + 31), relmax = kbase + 63 - (qpos0 + qrow0);
            if (relmin >= 128 || relmax <= -128) {
                const float bc = relmin >= 128 ? tab[256] : tab[0];
#pragma unroll
                for (int kt2 = 0; kt2 < 2; ++kt2)
#pragma unroll
                    for (int i = 0; i < 16; ++i) s[kt2][i] = s[kt2][i] * c1 + bc;
            } else {
#pragma unroll
                for (int kt2 = 0; kt2 < 2; ++kt2)
#pragma unroll
                    for (int i = 0; i < 16; ++i) {
                        const int kpos = kbase + kt2 * 32 + (i & 3) + 8 * (i >> 2) + 4 * h;
                        int idx = kpos - qpos + 128; idx = idx < 0 ? 0 : (idx > 256 ? 256 : idx);
                        s[kt2][i] = s[kt2][i] * c1 + tab[idx];
                    }
            }
        } else {
#pragma unroll
            for (int kt2 = 0; kt2 < 2; ++kt2)
#pragma unroll
                for (int i = 0; i < 16; ++i) s[kt2][i] *= c1;
        }
        float mx = s[0][0];
#pragma unroll
        for (int kt2 = 0; kt2 < 2; ++kt2)
#pragma unroll
            for (int i = 0; i < 16; ++i) mx = fmaxf(mx, s[kt2][i]);
        mx = fmaxf(mx, __shfl_xor(mx, 32));
        if (__any(mx > mthr)) {
            const float mn = fmaxf(m, mx), alpha = fexp2(m - mn);
            l *= alpha; m = mn; mthr = mn + 8.f;
#pragma unroll
            for (int et = 0; et < 4; ++et)
#pragma unroll
                for (int i = 0; i < 16; ++i) o[et][i] *= alpha;
        }
        bf16x8 pf[2][2];
#pragma unroll
        for (int kt2 = 0; kt2 < 2; ++kt2) {
            float p[16];
#pragma unroll
            for (int i = 0; i < 16; ++i) { p[i] = fexp2(s[kt2][i] - m); l += p[i]; }
#pragma unroll
            for (int sp = 0; sp < 2; ++sp) {
                u32x4 w; w.x = pk2(p[8 * sp + 0], p[8 * sp + 1]); w.y = pk2(p[8 * sp + 2], p[8 * sp + 3]); w.z = pk2(p[8 * sp + 4], p[8 * sp + 5]); w.w = pk2(p[8 * sp + 6], p[8 * sp + 7]);
                pf[kt2][sp] = __builtin_bit_cast(bf16x8, w);
            }
        }
#pragma unroll
        for (int et = 0; et < 4; ++et)
#pragma unroll
            for (int kt2 = 0; kt2 < 2; ++kt2)
#pragma unroll
                for (int sp = 0; sp < 2; ++sp) {
                    const LAS unsigned char* vp = lds + AT_V0 + cur * AT_VB + (et * 32 + ql) * 136 + (kt2 * 32 + sp * 16 + 4 * h) * 2;
                    const s16x4 lo = *(const LAS s16x4*)vp, hi = *(const LAS s16x4*)(vp + 16);
                    const bf16x8 a = __builtin_shufflevector(lo, hi, 0, 1, 2, 3, 4, 5, 6, 7);
                    o[et] = MFMA32(a, pf[kt2][sp], o[et]);
                }
        if (kt + 1 < nt) { if (!DIFF) AT_LOAD(kt + 1); AT_STORE(cur ^ 1); }
        __syncthreads();
    }
#undef AT_LOAD
#undef AT_STORE
    l += __shfl_xor(l, 32);
    const float inv = 1.f / l;
    if (DIFF) {
        const float sc = (c == 0) ? inv : -lam * inv;
        LAS float* ex = (LAS float*)(lds + AT_EX) + (qrow0 + ql) * 132;
        if (c == 1) {
#pragma unroll
            for (int et = 0; et < 4; ++et)
#pragma unroll
                for (int ig = 0; ig < 4; ++ig)
                    *(LAS f32x4*)(ex + 32 * et + 8 * ig + 4 * h) = (f32x4){o[et][4 * ig] * sc, o[et][4 * ig + 1] * sc, o[et][4 * ig + 2] * sc, o[et][4 * ig + 3] * sc};
        }
        __syncthreads();
        if (c == 0) {
            float ss = 0.f;
#pragma unroll
            for (int et = 0; et < 4; ++et)
#pragma unroll
                for (int ig = 0; ig < 4; ++ig) {
                    const f32x4 b = *(const LAS f32x4*)(ex + 32 * et + 8 * ig + 4 * h);
#pragma unroll
                    for (int j = 0; j < 4; ++j) { const float v = o[et][4 * ig + j] * sc + b[j]; o[et][4 * ig + j] = v; ss += v * v; }
                }
            ss += __shfl_xor(ss, 32);
            const float rr = rsqrtf(ss * (1.f / 128.f) + EPS) * 0.8f;
            bf16_t* op = O + (size_t)(qrow0 + ql) * ldo;
#pragma unroll
            for (int et = 0; et < 4; ++et)
#pragma unroll
                for (int ig = 0; ig < 4; ++ig) {
                    const int e0 = 32 * et + 8 * ig + 4 * h;
                    const f32x4 gg = *(const f32x4*)(gsub + e0);
                    u32x2 w; w.x = pk2(o[et][4 * ig] * rr * gg[0], o[et][4 * ig + 1] * rr * gg[1]); w.y = pk2(o[et][4 * ig + 2] * rr * gg[2], o[et][4 * ig + 3] * rr * gg[3]);
                    *(u32x2*)(op + e0) = w;
                }
        }
        __syncthreads();
    } else {
        bf16_t* op = O + (size_t)(qrow0 + ql) * ldo;
#pragma unroll
        for (int et = 0; et < 4; ++et)
#pragma unroll
            for (int ig = 0; ig < 4; ++ig) {
                const int e0 = 32 * et + 8 * ig + 4 * h;
                u32x2 w; w.x = pk2(o[et][4 * ig] * inv, o[et][4 * ig + 1] * inv); w.y = pk2(o[et][4 * ig + 2] * inv, o[et][4 * ig + 3] * inv);
                *(u32x2*)(op + e0) = w;
            }
    }
}

constexpr int HG_QS = 0, HG_KS = 17408, HG_KST = 34816, HG_VTS = 53248, HG_AS = 71680, HG_SEG = 80896, HG_ER = 84992, HG_EL = 85504;
template <int DIR>
DI void hgrn_item(LAS unsigned char* lds, const bf16_t* __restrict__ PROJ, const bf16_t* __restrict__ VT, int row0, int S, int head,
                  const float* __restrict__ lblog, bf16_t* __restrict__ Oout) {
    const int tid = otid(), w = tid >> 6, lane = tid & 63, r16 = lane & 15, quad = lane >> 4;
    const int dp = lane, seg = w, d0 = 2 * dp;
    float lb0, lb1;
    { const float* lp = lblog + DIR * 2048 + head * 128 + d0;
      lb0 = frcp(1.f + fexp(lp[1024] - lp[0])); lb1 = frcp(1.f + fexp(lp[1025] - lp[1])); }
    const float SC = 0.08838834764831845f;
    const int nch = S >> 6;
    f32x4 st[8];
#pragma unroll
    for (int i = 0; i < 8; ++i) st[i] = (f32x4){0.f, 0.f, 0.f, 0.f};
    unsigned zq[8], qq[8]; u32x4 vt[2];
    const bf16_t* zbase = PROJ + 3072 + DIR * 1024 + head * 128 + d0;
    const bf16_t* qbase = PROJ + 2048 + head * 128 + d0;
    const bf16_t* vbase = VT + (size_t)(1024 + head * 128 + (tid >> 3)) * GR + (tid & 7) * 8;
#define HG_LOAD(trow) do { _Pragma("unroll") for (int i = 0; i < 8; ++i) { const size_t ro = (size_t)((trow) + seg * 8 + i) * NPROJ; zq[i] = *(const unsigned*)(zbase + ro); qq[i] = *(const unsigned*)(qbase + ro); } \
        vt[0] = *(const u32x4*)(vbase + (trow)); vt[1] = *(const u32x4*)(vbase + (size_t)64 * GR + (trow)); } while (0)
    { const int n0 = DIR ? nch - 1 : 0; HG_LOAD(row0 + n0 * 64); }
    for (int ci = 0; ci < nch; ++ci) {
        const int n = DIR ? nch - 1 - ci : ci;
        const int trow = row0 + n * 64;
        float bl0[8], bl1[8], k0[8], k1[8], q0[8], q1[8];
        float run0 = 0.f, run1 = 0.f;
#pragma unroll
        for (int ii = 0; ii < 8; ++ii) { const int i = DIR ? 7 - ii : ii;
            const float z0 = bflo(zq[i]), z1 = bfhi(zq[i]);
            const float s0 = sigmoidf_(z0), s1 = sigmoidf_(z1);
            const float f0 = lb0 + (1.f - lb0) * s0, f1 = lb1 + (1.f - lb1) * s1;
            run0 += __logf(f0); run1 += __logf(f1);
            bl0[i] = run0; bl1[i] = run1;
            k0[i] = (1.f - lb0) * (1.f - s0); k1[i] = (1.f - lb1) * (1.f - s1);
            q0[i] = bflo(qq[i]) * SC; q1[i] = bfhi(qq[i]) * SC; }
        *(LAS f32x2*)(lds + HG_SEG + (seg * 128 + d0) * 4) = (f32x2){run0, run1};
        *(LAS u32x4*)(lds + HG_VTS + (tid >> 3) * 144 + (tid & 7) * 16) = vt[0];
        *(LAS u32x4*)(lds + HG_VTS + ((tid >> 3) + 64) * 144 + (tid & 7) * 16) = vt[1];
        __syncthreads();
        {
            float off0 = 0.f, off1 = 0.f, ref0 = 0.f, ref1 = 0.f, tot0 = 0.f, tot1 = 0.f;
#pragma unroll
            for (int s2 = 0; s2 < 8; ++s2) { const f32x2 t = *(const LAS f32x2*)(lds + HG_SEG + (s2 * 128 + d0) * 4);
                tot0 += t[0]; tot1 += t[1];
                const bool before = DIR ? (s2 > seg) : (s2 < seg);
                const bool inref = DIR ? (s2 >= 4) : (s2 < 4);
                if (before) { off0 += t[0]; off1 += t[1]; }
                if (inref) { ref0 += t[0]; ref1 += t[1]; } }
            unsigned kt0[4], kt1[4];
            float ksv0[8], ksv1[8];
#pragma unroll
            for (int i = 0; i < 8; ++i) {
                const float b0 = off0 + bl0[i] - ref0, b1 = off1 + bl1[i] - ref1;
                const float qs0 = q0[i] * fexp(b0), qs1 = q1[i] * fexp(b1);
                ksv0[i] = k0[i] * fexp(-b0); ksv1[i] = k1[i] * fexp(-b1);
                *(LAS unsigned*)(lds + HG_QS + (seg * 8 + i) * 272 + d0 * 2) = pk2(qs0, qs1);
                *(LAS unsigned*)(lds + HG_KS + (seg * 8 + i) * 272 + d0 * 2) = pk2(ksv0[i], ksv1[i]);
            }
#pragma unroll
            for (int i = 0; i < 4; ++i) { kt0[i] = pk2(ksv0[2 * i], ksv0[2 * i + 1]); kt1[i] = pk2(ksv1[2 * i], ksv1[2 * i + 1]); }
            *(LAS u32x4*)(lds + HG_KST + d0 * 144 + seg * 16) = (u32x4){kt0[0], kt0[1], kt0[2], kt0[3]};
            *(LAS u32x4*)(lds + HG_KST + (d0 + 1) * 144 + seg * 16) = (u32x4){kt1[0], kt1[1], kt1[2], kt1[3]};
            if (seg == 0) {
                *(LAS f32x2*)(lds + HG_ER + d0 * 4) = (f32x2){fexp(ref0), fexp(ref1)};
                *(LAS f32x2*)(lds + HG_EL + d0 * 4) = (f32x2){fexp(tot0 - ref0), fexp(tot1 - ref1)};
            }
        }
        if (ci + 1 < nch) { const int n2 = DIR ? n - 1 : n + 1; HG_LOAD(row0 + n2 * 64); }
        __syncthreads();
        bf16x8 vfr[2];
#pragma unroll
        for (int ks2 = 0; ks2 < 2; ++ks2) vfr[ks2] = *(const LAS bf16x8*)(lds + HG_VTS + (16 * w + r16) * 144 + (ks2 * 32 + quad * 8) * 2);
        {
            const int stl = w & 3;
#pragma unroll
            for (int tti = 0; tti < 2; ++tti) { const int tt = 2 * (w >> 2) + tti;
                f32x4 acc = (f32x4){0.f, 0.f, 0.f, 0.f};
#pragma unroll
                for (int ks = 0; ks < 4; ++ks) {
                    const bf16x8 a = *(const LAS bf16x8*)(lds + HG_KS + (16 * stl + r16) * 272 + (32 * ks + 8 * quad) * 2);
                    const bf16x8 b = *(const LAS bf16x8*)(lds + HG_QS + (16 * tt + r16) * 272 + (32 * ks + 8 * quad) * 2);
                    acc = MFMA16(a, b, acc);
                }
                const int t = 16 * tt + r16, sb = 16 * stl + 4 * quad;
#pragma unroll
                for (int j = 0; j < 4; ++j) { const bool keep = DIR ? (sb + j >= t) : (t >= sb + j); acc[j] = keep ? acc[j] : 0.f; }
                *(LAS u32x2*)(lds + HG_AS + t * 144 + sb * 2) = (u32x2){pk2(acc[0], acc[1]), pk2(acc[2], acc[3])};
            }
        }
        f32x4 oacc[4];
#pragma unroll
        for (int tt = 0; tt < 4; ++tt) oacc[tt] = (f32x4){0.f, 0.f, 0.f, 0.f};
#pragma unroll
        for (int ks = 0; ks < 4; ++ks) {
            const f32x4 ea = *(const LAS f32x4*)(lds + HG_ER + (32 * ks + 4 * quad) * 4), eb = *(const LAS f32x4*)(lds + HG_ER + (32 * ks + 16 + 4 * quad) * 4);
            st[2 * ks] *= ea; st[2 * ks + 1] *= eb;
            const u32x4 bw = (u32x4){pk2(st[2 * ks][0], st[2 * ks][1]), pk2(st[2 * ks][2], st[2 * ks][3]), pk2(st[2 * ks + 1][0], st[2 * ks + 1][1]), pk2(st[2 * ks + 1][2], st[2 * ks + 1][3])};
            const bf16x8 bfrag = __builtin_bit_cast(bf16x8, bw);
#pragma unroll
            for (int tt = 0; tt < 4; ++tt) {
                const LAS unsigned char* qp = lds + HG_QS + (16 * tt + r16) * 272 + (32 * ks + 4 * quad) * 2;
                const s16x4 lo = *(const LAS s16x4*)qp, hi = *(const LAS s16x4*)(qp + 32);
                const bf16x8 a = __builtin_shufflevector(lo, hi, 0, 1, 2, 3, 4, 5, 6, 7);
                oacc[tt] = MFMA16(a, bfrag, oacc[tt]);
            }
        }
#pragma unroll
        for (int dt = 0; dt < 8; ++dt) {
            f32x4 acc = st[dt];
#pragma unroll
            for (int ks2 = 0; ks2 < 2; ++ks2) {
                const bf16x8 a = *(const LAS bf16x8*)(lds + HG_KST + (16 * dt + r16) * 144 + (32 * ks2 + 8 * quad) * 2);
                acc = MFMA16(a, vfr[ks2], acc);
            }
            const f32x4 el = *(const LAS f32x4*)(lds + HG_EL + (16 * dt + 4 * quad) * 4);
            st[dt] = acc * el;
        }
        __syncthreads();
#pragma unroll
        for (int tt = 0; tt < 4; ++tt) {
#pragma unroll
            for (int ks2 = 0; ks2 < 2; ++ks2) {
                const bf16x8 a = *(const LAS bf16x8*)(lds + HG_AS + (16 * tt + r16) * 144 + (32 * ks2 + 8 * quad) * 2);
                oacc[tt] = MFMA16(a, vfr[ks2], oacc[tt]);
            }
#pragma unroll
            for (int j = 0; j < 4; ++j) {
                const int t = 16 * tt + 4 * quad + j;
                Oout[(size_t)(trow + t) * 1024 + head * 128 + 16 * w + r16] = (bf16_t)(pk2(oacc[tt][j], 0.f) & 0xffffu);
            }
        }
    }
#undef HG_LOAD
    __syncthreads();
}

typedef const __attribute__((address_space(4))) Params* CParams;
DI void run_step(CParams pp, int s, LAS unsigned char* lds) {
    asm volatile("" : "+s"(pp));
    const __attribute__((address_space(4))) Params& p = *pp;
    unsigned char* ws = p.ws;
    bf16_t* WIN = (bf16_t*)(ws + WS_WIN); bf16_t* WA = (bf16_t*)(ws + WS_WA); bf16_t* WB = (bf16_t*)(ws + WS_WB); bf16_t* WOUT = (bf16_t*)(ws + WS_WOUT);
    bf16_t* WQ = (bf16_t*)(ws + WS_WQ); bf16_t* WKV = (bf16_t*)(ws + WS_WKV); bf16_t* WO = (bf16_t*)(ws + WS_WO); bf16_t* WGU = (bf16_t*)(ws + WS_WGU); bf16_t* WD = (bf16_t*)(ws + WS_WD);
    bf16_t* MN = (bf16_t*)(ws + WS_MN); bf16_t* KX = (bf16_t*)(ws + WS_KX); bf16_t* VXT = (bf16_t*)(ws + WS_VXT);
    unsigned* CTR = (unsigned*)(ws + WS_CTR);
    bf16_t* H = (bf16_t*)(ws + WS_H); bf16_t* PROJ = (bf16_t*)(ws + WS_PROJ); bf16_t* ACT = PROJ; bf16_t* VT = (bf16_t*)(ws + WS_VT);
    bf16_t* YA = (bf16_t*)(ws + WS_YA); bf16_t* YB = (bf16_t*)(ws + WS_YB); bf16_t* QX = YA; bf16_t* OX = YB;
    bf16_t* OF = (bf16_t*)(ws + WS_OF); bf16_t* OB = (bf16_t*)(ws + WS_OB); bf16_t* Y = (bf16_t*)(ws + WS_Y);
    const int tid = otid();
    if (s == 0) {
        if (blockIdx.x == 0 && tid < 64) CTR[tid] = 0u;
        const int T0 = 32 * 192, T1 = 16 * 32, T2 = 16 * 32, T3 = 32 * 32, T4 = 32 * 8, T5 = 32 * 16, T6 = 8 * 32, T7 = 32 * 176, T8 = 88 * 32;
        const int TT = T0 + T1 + T2 + T3 + T4 + T5 + T6 + T7 + T8;
        for (int it = blockIdx.x; it < TT; it += gridDim.x) {
            int r = it;
            if (r < T0) { transpose_tile(p.in[7], 2048, 12288, WIN, 1, r, lds); continue; } r -= T0;
            if (r < T1) { transpose_tile(p.in[15], 1024, 2048, WA, 0, r, lds); continue; } r -= T1;
            if (r < T2) { transpose_tile(p.in[16], 1024, 2048, WB, 0, r, lds); continue; } r -= T2;
            if (r < T3) { transpose_tile(p.in[17], 2048, 2048, WOUT, 0, r, lds); continue; } r -= T3;
            if (r < T4) { transpose_tile(p.in[21], 2048, 512, WQ, 0, r, lds); continue; } r -= T4;
            if (r < T5) { transpose_tile(p.in[22], 2048, 1024, WKV, 0, r, lds); continue; } r -= T5;
            if (r < T6) { transpose_tile(p.in[23], 512, 2048, WO, 0, r, lds); continue; } r -= T6;
            if (r < T7) { transpose_tile(p.in[26], 2048, 11264, WGU, 2, r, lds); continue; } r -= T7;
            transpose_tile(p.in[27], 5632, 2048, WD, 0, r, lds);
        }
        rowpass(p.in[2], nullptr, nullptr, nullptr, p.in[20], MN, 4096);
        rowpass(p.in[3], nullptr, nullptr, nullptr, p.in[20], MN + (size_t)4096 * DM, 1024);
        return;
    }
    const int g = (s - 1) / NPH, ph = (s - 1) % NPH;
    const bool isP = g < 2;
    const int S = isP ? 2048 : 8192, nseq = GR / S, seqbase = isP ? g * 8 : 16 + (g - 2) * 2;
    const float* xin = isP ? p.in[0] + (size_t)g * GR * DM : p.in[1] + (size_t)(g - 2) * GR * DM;
    float* xo = p.out + (size_t)g * GR * DM;
#ifndef PHMASK
#define PHMASK 0xFFFF
#endif
    if (!((PHMASK >> ph) & 1)) return;
    switch (ph) {
    case 0: rowpass(xin, nullptr, nullptr, nullptr, p.in[6], H, GR); break;
    case 1: {
        { pg8::EpiBf16<1> E; E.O = PROJ; E.ldc = NPROJ; E.bias = p.in[8]; run_gemm(lds, H, WIN, GR, NPROJ, DM, E); }
        { pg8::EpiBf16<0> E; E.O = VT; E.ldc = GR; E.bias = nullptr; run_gemm(lds, WIN + (size_t)NPROJ * DM, H, 2048, GR, DM, E); }
        if (g == 0) {
            { pg8::EpiBf16<0> E; E.O = KX; E.ldc = 512; E.bias = nullptr; run_gemm(lds, MN, WKV, NMEMROWS, 512, DM, E, 64); }
            { pg8::EpiBf16<0> E; E.O = VXT; E.ldc = NMEMROWS; E.bias = nullptr; run_gemm(lds, WKV + (size_t)512 * DM, MN, 512, NMEMROWS, DM, E, 128); }
        }
    } break;
    case 2: {
        const float lam = fexp(wave_sum(p.in[9][tid & 63] * p.in[10][tid & 63])) - fexp(wave_sum(p.in[11][tid & 63] * p.in[12][tid & 63])) + 0.2f;
        const int n_hg = nseq * 16, nqb = S / 128, n_at = nseq * 8 * nqb, total = n_hg + n_at;
        LAS int* sitem = (LAS int*)(lds + LDS_BYTES - 16);
        for (;;) {
            if (tid == 0) *sitem = (int)atomicAdd(&CTR[g], 1u);
            __syncthreads();
            const int item = *sitem;
            __syncthreads();
            if (item >= total) break;
            if (item < n_hg) {
                const int sl = item >> 4, head = (item >> 1) & 7, dir = item & 1;
                if (dir == 0) hgrn_item<0>(lds, PROJ, VT, sl * S, S, head, p.in[5], OF);
                else hgrn_item<1>(lds, PROJ, VT, sl * S, S, head, p.in[5], OB);
            } else {
                const int a = item - n_hg, sl = a / (8 * nqb), rem = a - sl * 8 * nqb, head = rem / nqb, qb = rem - head * nqb;
                attn_unit<4, true>(lds, PROJ + (size_t)(sl * S + qb * 128) * NPROJ + head * 128, NPROJ,
                                   PROJ + (size_t)(sl * S) * NPROJ + 1024 + head * 128, NPROJ,
                                   VT + (size_t)(head * 128) * GR + sl * S, (size_t)GR, S, qb * 128, p.in[4] + head, lam, p.in[13],
                                   YA + (size_t)(sl * S + qb * 128) * 1024 + head * 128, 1024, 0.125f * LOG2E);
            }
        }
    } break;
    case 3: hgrn_combine(OF, OB, PROJ, p.in[14], YB, GR); break;
    case 4: {
        { pg8::EpiGate<false> E; E.O = H; E.ldc = DM; E.Gt = PROJ + 6144; E.ldg = NPROJ; run_gemm(lds, YA, WA, GR, DM, 1024, E); }
        { pg8::EpiGate<true> E; E.O = H; E.ldc = DM; E.Gt = PROJ + 8192; E.ldg = NPROJ; run_gemm(lds, YB, WB, GR, DM, 1024, E); }
    } break;
    case 5: { pg8::EpiBf16<0> E; E.O = Y; E.ldc = DM; E.bias = nullptr; run_gemm(lds, H, WOUT, GR, DM, DM, E); } break;
    case 6: rowpass(xin, Y, p.in[18], xo, p.in[19], H, GR); break;
    case 7: { pg8::EpiBf16<0> E; E.O = QX; E.ldc = 512; E.bias = nullptr; run_gemm(lds, H, WQ, GR, 512, DM, E); } break;
    case 8: {
        for (int u = blockIdx.x; u < (GR / 256) * 4; u += gridDim.x) {
            const int head = u & 3, qb = u >> 2, l0 = qb * 256, memseq = seqbase + l0 / S;
            attn_unit<8, false>(lds, QX + (size_t)l0 * 512 + head * 128, 512, KX + (size_t)(memseq * 256) * 512 + head * 128, 512,
                                VXT + (size_t)(head * 128) * NMEMROWS + memseq * 256, (size_t)NMEMROWS, 256, 0, nullptr, 0.f, nullptr,
                                OX + (size_t)l0 * 512 + head * 128, 512, 0.08838834764831845f * LOG2E);
        }
    } break;
    case 9: { pg8::EpiBf16<0> E; E.O = Y; E.ldc = DM; E.bias = nullptr; run_gemm(lds, OX, WO, GR, DM, 512, E); } break;
    case 10: rowpass(xo, Y, p.in[24], xo, p.in[25], H, GR); break;
    case 11: { pg8::EpiSwiGLU E; E.O = ACT; E.ldc = DFF; run_gemm(lds, H, WGU, GR, 2 * DFF, DM, E); } break;
    case 12: { pg8::EpiBf16<0> E; E.O = Y; E.ldc = DM; E.bias = nullptr; run_gemm(lds, ACT, WD, GR, DM, DFF, E); } break;
    case 13: rowpass(xo, Y, p.in[28], xo, nullptr, nullptr, GR); break;
    }
}

__global__ void __launch_bounds__(512, 2) mk_fwd(Params p) {
    extern __shared__ __attribute__((aligned(16))) unsigned char shm[];
    LAS unsigned char* lds = (LAS unsigned char*)shm;
    CParams pp = (CParams)__builtin_amdgcn_kernarg_segment_ptr();
    for (int s = p.lo; s < p.hi; ++s) {
        run_step(pp, s, lds);
        if (s + 1 < p.hi) { __syncthreads(); cg::this_grid().sync(); }
    }
}

extern "C" void kernel_launch(void* const* d_in, const int* in_sizes, int n_in, void* d_out, int out_size, void* d_ws, size_t ws_size, hipStream_t stream) {
    static int grid = 0;
    if (grid == 0) {
        if (n_in != 29 || ws_size < WS_END) { fprintf(stderr, "kernel_launch: unexpected n_in %d or ws_size %zu (< %zu)\n", n_in, ws_size, (size_t)WS_END); grid = -1; return; }
        int dev = 0, cus = 0, per_cu = 0;
        (void)hipGetDevice(&dev);
        (void)hipDeviceGetAttribute(&cus, hipDeviceAttributeMultiprocessorCount, dev);
        if (hipFuncSetAttribute((const void*)mk_fwd, hipFuncAttributeMaxDynamicSharedMemorySize, LDS_BYTES) != hipSuccess) { fprintf(stderr, "kernel_launch: hipFuncSetAttribute failed\n"); grid = -1; return; }
        if (hipOccupancyMaxActiveBlocksPerMultiprocessor(&per_cu, (const void*)mk_fwd, 512, LDS_BYTES) != hipSuccess || per_cu < 1) { fprintf(stderr, "kernel_launch: occupancy query %d\n", per_cu); per_cu = 1; (void)hipGetLastError(); }
        grid = cus * 1;
    }
    if (grid < 0) return;
    Params p{};
    for (int i = 0; i < 29; ++i) p.in[i] = (const float*)d_in[i];
    p.out = (float*)d_out; p.ws = (unsigned char*)d_ws;
#if MK_COOP
    p.lo = 0; p.hi = NSTEPS;
    void* args[] = {&p};
    hipError_t e = hipLaunchCooperativeKernel((const void*)mk_fwd, dim3(grid), dim3(512), args, LDS_BYTES, stream);
    if (e != hipSuccess) fprintf(stderr, "cooperative launch failed: %s (grid %d)\n", hipGetErrorString(e), grid);
#else
    for (int s = 0; s < NSTEPS; ++s) { p.lo = s; p.hi = s + 1; hipLaunchKernelGGL(mk_fwd, dim3(grid), dim3(512), LDS_BYTES, stream, p); }
#endif
}
#ifdef RES_TEST
#define TK(name, body) __global__ void __launch_bounds__(512, 2) name(Params p) { extern __shared__ __attribute__((aligned(16))) unsigned char shm[]; LAS unsigned char* lds = (LAS unsigned char*)shm; body }
TK(t_step0, run_step((CParams)__builtin_amdgcn_kernarg_segment_ptr(), 0, lds);)
TK(t_ph0, run_step((CParams)__builtin_amdgcn_kernarg_segment_ptr(), 1 + 0, lds);)
TK(t_ph1, run_step((CParams)__builtin_amdgcn_kernarg_segment_ptr(), 1 + 1, lds);)
TK(t_ph2, run_step((CParams)__builtin_amdgcn_kernarg_segment_ptr(), 1 + 2, lds);)
TK(t_ph3, run_step((CParams)__builtin_amdgcn_kernarg_segment_ptr(), 1 + 3, lds);)
TK(t_ph4, run_step((CParams)__builtin_amdgcn_kernarg_segment_ptr(), 1 + 4, lds);)
TK(t_ph5, run_step((CParams)__builtin_amdgcn_kernarg_segment_ptr(), 1 + 5, lds);)
TK(t_ph6, run_step((CParams)__builtin_amdgcn_kernarg_segment_ptr(), 1 + 6, lds);)
TK(t_ph8, run_step((CParams)__builtin_amdgcn_kernarg_segment_ptr(), 1 + 8, lds);)
TK(t_ph11, run_step((CParams)__builtin_amdgcn_kernarg_segment_ptr(), 1 + 11, lds);)
TK(t_hg0, hgrn_item<0>(lds, (const bf16_t*)p.ws, (const bf16_t*)p.ws, p.lo, p.hi, 1, p.in[5], (bf16_t*)p.out);)
TK(t_hg1, hgrn_item<1>(lds, (const bf16_t*)p.ws, (const bf16_t*)p.ws, p.lo, p.hi, 1, p.in[5], (bf16_t*)p.out);)
TK(t_at, (attn_unit<4, true>(lds, (const bf16_t*)p.ws, NPROJ, (const bf16_t*)p.ws, NPROJ, (const bf16_t*)p.ws, (size_t)GR, p.hi, p.lo, p.in[4], 0.3f, p.in[13], (bf16_t*)p.out, 1024, 0.18f));)
TK(t_xat, (attn_unit<8, false>(lds, (const bf16_t*)p.ws, NPROJ, (const bf16_t*)p.ws, NPROJ, (const bf16_t*)p.ws, (size_t)GR, p.hi, p.lo, p.in[4], 0.3f, p.in[13], (bf16_t*)p.out, 1024, 0.18f));)
#endif
```

```cpp
#include <hip/hip_runtime.h>
#include <hip/hip_cooperative_groups.h>
#include <cstdio>
#include <cstdint>
namespace cg = cooperative_groups;

#ifndef MK_COOP
#define MK_COOP 1
#endif

#define LAS __attribute__((address_space(3)))
#define DI __device__ __forceinline__
typedef unsigned short bf16_t;
typedef short bf16x8 __attribute__((ext_vector_type(8)));
typedef short s16x4 __attribute__((ext_vector_type(4)));
typedef float f32x4 __attribute__((ext_vector_type(4)));
typedef float f32x2 __attribute__((ext_vector_type(2)));
typedef float f32x16 __attribute__((ext_vector_type(16)));
typedef unsigned u32x4 __attribute__((ext_vector_type(4)));
typedef unsigned u32x2 __attribute__((ext_vector_type(2)));

constexpr int DM = 2048, NPROJ = 10240, DFF = 5632;
constexpr int GR = 16384;
constexpr int NGROUP = 4;
constexpr int NMEMROWS = 5120;
constexpr float EPS = 1e-6f;
constexpr float LOG2E = 1.4426950408889634f;
constexpr int LDS_BYTES = 143360;
constexpr int NPH = 14;
constexpr int NSTEPS = 1 + NGROUP * NPH;

constexpr size_t WS_WIN = 0;
constexpr size_t WS_WA = WS_WIN + (size_t)12288 * 2048 * 2;
constexpr size_t WS_WB = WS_WA + (size_t)2048 * 1024 * 2;
constexpr size_t WS_WOUT = WS_WB + (size_t)2048 * 1024 * 2;
constexpr size_t WS_WQ = WS_WOUT + (size_t)2048 * 2048 * 2;
constexpr size_t WS_WKV = WS_WQ + (size_t)512 * 2048 * 2;
constexpr size_t WS_WO = WS_WKV + (size_t)1024 * 2048 * 2;
constexpr size_t WS_WGU = WS_WO + (size_t)2048 * 512 * 2;
constexpr size_t WS_WD = WS_WGU + (size_t)11264 * 2048 * 2;
constexpr size_t WS_MN = WS_WD + (size_t)2048 * 5632 * 2;
constexpr size_t WS_KX = WS_MN + (size_t)NMEMROWS * 2048 * 2;
constexpr size_t WS_VXT = WS_KX + (size_t)NMEMROWS * 512 * 2;
constexpr size_t WS_CTR = WS_VXT + (size_t)NMEMROWS * 512 * 2;
constexpr size_t WS_BAR = WS_CTR + 1024;
constexpr size_t WS_H = WS_CTR + 16384;
constexpr size_t WS_PROJ = WS_H + (size_t)GR * 2048 * 2;
constexpr size_t WS_VT = WS_PROJ + (size_t)GR * NPROJ * 2;
constexpr size_t WS_YA = WS_VT + (size_t)2048 * GR * 2;
constexpr size_t WS_YB = WS_YA + (size_t)GR * 1024 * 2;
constexpr size_t WS_OF = WS_YB + (size_t)GR * 1024 * 2;
constexpr size_t WS_OB = WS_OF + (size_t)GR * 1024 * 2;
constexpr size_t WS_Y = WS_OB + (size_t)GR * 1024 * 2;
constexpr size_t WS_END = WS_Y + (size_t)GR * 2048 * 2;

struct Params {
    const float* in[29];
    float* out;
    unsigned char* ws;
    int lo, hi;
};

DI float bf2f(bf16_t b) { return __uint_as_float(((unsigned)b) << 16); }
DI float bflo(unsigned u) { return __uint_as_float(u << 16); }
DI float bfhi(unsigned u) { return __uint_as_float(u & 0xffff0000u); }
typedef __bf16 bfx2_t __attribute__((ext_vector_type(2)));
DI unsigned pk2(float lo, float hi) { const f32x2 v = {lo, hi}; const bfx2_t b = __builtin_convertvector(v, bfx2_t); return __builtin_bit_cast(unsigned, b); }
DI float fexp2(float x) { return __builtin_amdgcn_exp2f(x); }
DI float fexp(float x) { return __builtin_amdgcn_exp2f(x * LOG2E); }
DI float frcp(float x) { return __builtin_amdgcn_rcpf(x); }
DI float sigmoidf_(float x) { return frcp(1.f + fexp(-x)); }
DI float siluf_(float x) { return x * frcp(1.f + fexp(-x)); }
DI float wave_sum(float v) {
#pragma unroll
    for (int o = 1; o < 64; o <<= 1) v += __shfl_xor(v, o);
    return v;
}
DI int otid() { int t = threadIdx.x; asm volatile("" : "+v"(t)); return t; }
#define MFMA16(a, b, c) __builtin_amdgcn_mfma_f32_16x16x32_bf16((a), (b), (c), 0, 0, 0)
#define MFMA32(a, b, c) __builtin_amdgcn_mfma_f32_32x32x16_bf16((a), (b), (c), 0, 0, 0)

namespace pg8 {
constexpr int BM = 256, BK = 64, HALF = 128, HTB = HALF * BK * 2, STAGE_BYTES = 8 * HTB, NXCD = 8, WGM = 8;
__host__ __device__ __forceinline__ int lds_byte(int r, int c) { const int st = (r >> 4) * 2 + (c >> 5), rr = r & 15, cc = c & 31, ob = rr * 64 + cc * 2; return st * 1024 + (ob ^ (((ob >> 9) & 1) << 5)); }
__host__ __device__ __forceinline__ void stage_rc(int b, int& R, int& C) { const int st = b / 1024, sb = b % 1024, swz = sb ^ (((sb >> 9) & 1) << 5); R = (st >> 1) * 16 + swz / 64; C = (st & 1) * 32 + (swz % 64) / 2; }
__host__ __device__ __forceinline__ int perm32(int rho) { const int n = rho >> 4, i = rho & 15; return 8 * (i >> 2) + 4 * n + (i & 3); }
struct Unit { int pm, pn; };
struct Gemm { const bf16_t* A; const bf16_t* Bt; int M, N, K; };
struct StaticOrder {
    int nM, nN, nwg, G, c;
    __device__ void init(int M, int N, int G_, int c_) { nM = M / BM; nN = N / BM; nwg = nM * nN; G = G_; c = c_; }
    __device__ bool next(int i, Unit& u) const {
        const long L = (long)i * G + c; if (L >= nwg) return false;
        int wgid = (int)L; { const int q = nwg / NXCD, r = nwg % NXCD, xcd = wgid % NXCD, off = wgid / NXCD; wgid = (xcd < r ? xcd * (q + 1) : r * (q + 1) + (xcd - r) * q) + off; }
        const int nig = WGM * nN, gid = wgid / nig, fm = gid * WGM, gsz = (nM - fm) < WGM ? (nM - fm) : WGM;
        u.pm = fm + ((wgid % nig) % gsz); u.pn = (wgid % nig) / gsz; return true;
    }
};

template <class Epi>
__device__ __forceinline__ void gemm_phase(LAS unsigned char* lds, const Gemm g, const StaticOrder& S, const Epi& E) {
    const int tid = otid(), wid = __builtin_amdgcn_readfirstlane(tid >> 6), lane = tid & 63, wr = wid >> 2, wc = wid & 3, fr = lane & 15, fq = lane >> 4;
    const int K = g.K, nt = K / BK;
    unsigned voffA[2], voffB[2];
#pragma unroll
    for (int i = 0; i < 2; ++i) { int R, C; stage_rc(tid * 16 + i * 8192, R, C); const int Rb = (R & ~31) + perm32(R & 31);
        voffA[i] = (unsigned)(R * K + C) * 2u; voffB[i] = (unsigned)(Rb * K + C) * 2u; }
    const size_t kstep = (size_t)(BK * 2);
    const size_t hstep = (size_t)HALF * K * 2;
    const size_t tstep = 2 * hstep;
    const unsigned ldsw = (unsigned)wid * 1024u;
    const int aoff = lds_byte(wr * 64 + fr, fq * 8), boff = lds_byte(wc * 32 + fr, fq * 8);
#define PG8_SA(b, h) (((b) * 2 + (h)) * HTB)
#define PG8_SB(b, h) ((4 + (b) * 2 + (h)) * HTB)
#define PG8_STAGE(bufoff, gbase, voff) do { _Pragma("unroll") for (int _i = 0; _i < 2; ++_i) \
        __builtin_amdgcn_global_load_lds((const unsigned*)((const char*)(gbase) + (voff)[_i]), (LAS unsigned*)(lds + (bufoff) + ldsw + _i * 8192), 16, 0, 0); } while (0)
#define PG8_LDA(dst, b, h) do { _Pragma("unroll") for (int m = 0; m < 4; ++m) _Pragma("unroll") for (int k = 0; k < 2; ++k) dst[m][k] = *(const LAS bf16x8*)(lds + PG8_SA(b, h) + aoff + m * 2048 + k * 1024); } while (0)
#define PG8_LDB(dst, b, h) do { _Pragma("unroll") for (int n = 0; n < 2; ++n) _Pragma("unroll") for (int k = 0; k < 2; ++k) dst[n][k] = *(const LAS bf16x8*)(lds + PG8_SB(b, h) + boff + n * 2048 + k * 1024); } while (0)
#define PG8_MMA(ai, bj, At, Bt) do { __builtin_amdgcn_s_setprio(1); _Pragma("unroll") for (int m = 0; m < 4; ++m) _Pragma("unroll") for (int n = 0; n < 2; ++n) _Pragma("unroll") for (int k = 0; k < 2; ++k) \
        acc[ai][bj][m][n] = __builtin_amdgcn_mfma_f32_16x16x32_bf16(Bt[n][k], At[m][k], acc[ai][bj][m][n], 0, 0, 0); __builtin_amdgcn_s_setprio(0); } while (0)
#define PG8_WAIT_V(n) asm volatile("s_waitcnt vmcnt(" #n ")" ::: "memory")
#define PG8_WAIT_L(n) asm volatile("s_waitcnt lgkmcnt(" #n ")" ::: "memory")
#define PG8_BAR __builtin_amdgcn_s_barrier()
#define PG8_SCHED __builtin_amdgcn_sched_barrier(0)
    Unit cur, nxt; int ui = 0;
    if (!S.next(0, cur)) return;
    f32x4 acc[2][2][4][2];
#pragma unroll
    for (int a = 0; a < 2; ++a)
#pragma unroll
        for (int b = 0; b < 2; ++b)
#pragma unroll
            for (int m = 0; m < 4; ++m)
#pragma unroll
                for (int n = 0; n < 2; ++n) acc[a][b][m][n] = (f32x4){0.f, 0.f, 0.f, 0.f};
    bf16x8 At[4][2], B0[2][2], B1[2][2];
    const char* cA = (const char*)g.A + (size_t)cur.pm * tstep; const char* cB = (const char*)g.Bt + (size_t)cur.pn * tstep;
    PG8_STAGE(PG8_SB(0, 0), cB, voffB); PG8_STAGE(PG8_SA(0, 0), cA, voffA); PG8_STAGE(PG8_SB(0, 1), cB + hstep, voffB); PG8_STAGE(PG8_SA(0, 1), cA + hstep, voffA);
    if (wr == 1) PG8_BAR;
    PG8_WAIT_V(4); PG8_BAR;
    PG8_STAGE(PG8_SB(1, 0), cB + kstep, voffB); PG8_STAGE(PG8_SA(1, 0), cA + kstep, voffA); PG8_STAGE(PG8_SB(1, 1), cB + hstep + kstep, voffB);
    PG8_WAIT_V(6); PG8_BAR;
    for (;;) {
        const bool has_next = S.next(ui + 1, nxt);
        const char* nA = has_next ? (const char*)g.A + (size_t)nxt.pm * tstep : cA; const char* nB = has_next ? (const char*)g.Bt + (size_t)nxt.pn * tstep : cB;
        for (int t = 0; t < nt; t += 2) {
            const bool last = (t == nt - 2);
            const char* a1 = cA + (size_t)(t + 1) * kstep;
            const char* a2 = last ? nA : cA + (size_t)(t + 2) * kstep; const char* b2 = last ? nB : cB + (size_t)(t + 2) * kstep;
            const char* a3 = a2 + kstep; const char* b3 = b2 + kstep;
            PG8_LDB(B0, 0, 0); PG8_SCHED; PG8_LDA(At, 0, 0); PG8_STAGE(PG8_SA(1, 1), a1 + hstep, voffA);
            PG8_WAIT_L(8); PG8_BAR; PG8_WAIT_L(0); PG8_MMA(0, 0, At, B0); PG8_BAR; PG8_SCHED;
            PG8_LDB(B1, 0, 1); PG8_STAGE(PG8_SB(0, 0), b2, voffB);
            PG8_BAR; PG8_WAIT_L(0); PG8_MMA(0, 1, At, B1); PG8_BAR;
            PG8_LDA(At, 0, 1); PG8_STAGE(PG8_SA(0, 0), a2, voffA);
            PG8_BAR; PG8_WAIT_L(0); PG8_MMA(1, 0, At, B0); PG8_BAR; PG8_SCHED;
            PG8_STAGE(PG8_SB(0, 1), b2 + hstep, voffB);
            PG8_WAIT_V(6); PG8_BAR; PG8_MMA(1, 1, At, B1); PG8_BAR;
            PG8_LDB(B0, 1, 0); PG8_SCHED; PG8_LDA(At, 1, 0); PG8_STAGE(PG8_SA(0, 1), a2 + hstep, voffA);
            PG8_WAIT_L(8); PG8_BAR; PG8_WAIT_L(0); PG8_MMA(0, 0, At, B0); PG8_BAR; PG8_SCHED;
            PG8_LDB(B1, 1, 1); PG8_STAGE(PG8_SB(1, 0), b3, voffB);
            PG8_BAR; PG8_WAIT_L(0); PG8_MMA(0, 1, At, B1); PG8_BAR;
            PG8_LDA(At, 1, 1); PG8_STAGE(PG8_SA(1, 0), a3, voffA);
            PG8_BAR; PG8_WAIT_L(0); PG8_MMA(1, 0, At, B0); PG8_BAR; PG8_SCHED;
            PG8_STAGE(PG8_SB(1, 1), b3 + hstep, voffB);
            PG8_WAIT_V(6); PG8_BAR; PG8_MMA(1, 1, At, B1); PG8_BAR;
        }
        E(acc, cur, wr, wc, fr, fq);
        if (!has_next) break;
#pragma unroll
        for (int a = 0; a < 2; ++a)
#pragma unroll
            for (int b = 0; b < 2; ++b)
#pragma unroll
                for (int m = 0; m < 4; ++m)
#pragma unroll
                    for (int n = 0; n < 2; ++n) acc[a][b][m][n] = (f32x4){0.f, 0.f, 0.f, 0.f};
        cur = nxt; cA = nA; cB = nB; ++ui;
    }
    PG8_WAIT_V(0);
    if (wr == 0) PG8_BAR;
    PG8_BAR;
#undef PG8_SA
#undef PG8_SB
#undef PG8_STAGE
#undef PG8_LDA
#undef PG8_LDB
#undef PG8_MMA
#undef PG8_WAIT_V
#undef PG8_WAIT_L
#undef PG8_BAR
#undef PG8_SCHED
}

template <int MODE> struct EpiBf16 {
    bf16_t* O; int ldc; const float* bias;
    DI void operator()(const f32x4 (&acc)[2][2][4][2], const Unit& u, int wr, int wc, int fr, int fq) const {
        const int row0 = u.pm * BM + wr * 64 + fr, col0 = u.pn * BM + wc * 32 + 8 * fq;
        const bool gate = (MODE == 1) && (u.pn >= 24);
        f32x4 bv[2][2];
#pragma unroll
        for (int bj = 0; bj < 2; ++bj)
#pragma unroll
            for (int n = 0; n < 2; ++n) bv[bj][n] = gate ? *(const f32x4*)(bias + (col0 - 6144) + bj * HALF + 4 * n) : (f32x4){0.f, 0.f, 0.f, 0.f};
#pragma unroll
        for (int ai = 0; ai < 2; ++ai)
#pragma unroll
            for (int m = 0; m < 4; ++m) { bf16_t* rowp = O + (size_t)(row0 + ai * HALF + m * 16) * ldc + col0;
#pragma unroll
                for (int bj = 0; bj < 2; ++bj) { f32x4 v0 = acc[ai][bj][m][0], v1 = acc[ai][bj][m][1];
                    if (gate) {
#pragma unroll
                        for (int j = 0; j < 4; ++j) { v0[j] = sigmoidf_(v0[j] + bv[bj][0][j]); v1[j] = sigmoidf_(v1[j] + bv[bj][1][j]); } }
                    u32x4 w; w.x = pk2(v0[0], v0[1]); w.y = pk2(v0[2], v0[3]); w.z = pk2(v1[0], v1[1]); w.w = pk2(v1[2], v1[3]);
                    *(u32x4*)(rowp + bj * HALF) = w; } }
    }
};
template <bool ACCUM> struct EpiGate {
    bf16_t* O; int ldc; const bf16_t* Gt; int ldg;
    DI void operator()(const f32x4 (&acc)[2][2][4][2], const Unit& u, int wr, int wc, int fr, int fq) const {
        const int row0 = u.pm * BM + wr * 64 + fr, col0 = u.pn * BM + wc * 32 + 8 * fq;
#pragma unroll
        for (int ai = 0; ai < 2; ++ai)
#pragma unroll
            for (int m = 0; m < 4; ++m) { const size_t row = (size_t)(row0 + ai * HALF + m * 16);
#pragma unroll
                for (int bj = 0; bj < 2; ++bj) {
                    const u32x4 gv = *(const u32x4*)(Gt + row * ldg + col0 + bj * HALF);
                    bf16_t* op = O + row * ldc + col0 + bj * HALF;
                    f32x4 v0 = acc[ai][bj][m][0], v1 = acc[ai][bj][m][1];
                    v0[0] *= bflo(gv.x); v0[1] *= bfhi(gv.x); v0[2] *= bflo(gv.y); v0[3] *= bfhi(gv.y);
                    v1[0] *= bflo(gv.z); v1[1] *= bfhi(gv.z); v1[2] *= bflo(gv.w); v1[3] *= bfhi(gv.w);
                    if (ACCUM) { const u32x4 pv = *(const u32x4*)op;
                        v0[0] += bflo(pv.x); v0[1] += bfhi(pv.x); v0[2] += bflo(pv.y); v0[3] += bfhi(pv.y);
                        v1[0] += bflo(pv.z); v1[1] += bfhi(pv.z); v1[2] += bflo(pv.w); v1[3] += bfhi(pv.w); }
                    u32x4 w; w.x = pk2(v0[0], v0[1]); w.y = pk2(v0[2], v0[3]); w.z = pk2(v1[0], v1[1]); w.w = pk2(v1[2], v1[3]);
                    *(u32x4*)op = w; } }
    }
};
struct EpiSwiGLU {
    bf16_t* O; int ldc;
    DI void operator()(const f32x4 (&acc)[2][2][4][2], const Unit& u, int wr, int wc, int fr, int fq) const {
        const int row0 = u.pm * BM + wr * 64 + fr, col0 = u.pn * HALF + wc * 32 + 8 * fq;
#pragma unroll
        for (int ai = 0; ai < 2; ++ai)
#pragma unroll
            for (int m = 0; m < 4; ++m) { bf16_t* op = O + (size_t)(row0 + ai * HALF + m * 16) * ldc + col0;
                f32x4 v0, v1;
#pragma unroll
                for (int j = 0; j < 4; ++j) { v0[j] = siluf_(acc[ai][0][m][0][j]) * acc[ai][1][m][0][j]; v1[j] = siluf_(acc[ai][0][m][1][j]) * acc[ai][1][m][1][j]; }
                u32x4 w; w.x = pk2(v0[0], v0[1]); w.y = pk2(v0[2], v0[3]); w.z = pk2(v1[0], v1[1]); w.w = pk2(v1[2], v1[3]);
                *(u32x4*)op = w; }
    }
};
}

template <class Epi>
DI void run_gemm(LAS unsigned char* lds, const bf16_t* A, const bf16_t* Bt, int M, int N, int K, const Epi& E, int cshift = 0) {
    pg8::Gemm g; g.A = A; g.Bt = Bt; g.M = M; g.N = N; g.K = K;
    pg8::StaticOrder S; S.init(M, N, (int)gridDim.x, (int)((blockIdx.x + cshift) % gridDim.x));
    pg8::gemm_phase<Epi>(lds, g, S, E);
}

DI int rowmap(int mode, int n) {
    if (mode == 0) return n;
    if (mode == 1) {
        if (n < 2048) return n;
        if (n < 3072) return 10240 + (n - 2048);
        if (n < 6144) return n - 1024;
        if (n < 7168) return 11264 + (n - 6144);
        if (n < 8192) return 5120 + (n - 7168);
        return 6144 + (n - 8192);
    }
    const int up = n >= DFF, j = up ? n - DFF : n;
    return 256 * (j >> 7) + (up ? 128 : 0) + (j & 127);
}
DI void transpose_tile(const float* __restrict__ W, int K, int N, bf16_t* __restrict__ WT, int mode, int tile, LAS unsigned char* lds) {
    const int tid = otid();
    const int nb = N >> 6, kb = tile / nb, nbk = tile - kb * nb, k0 = kb << 6, n0 = nbk << 6;
    LAS bf16_t* T = (LAS bf16_t*)lds;
    const int r = tid >> 4, c4 = (tid & 15) * 4;
#pragma unroll
    for (int i = 0; i < 2; ++i) { const int kk = r + 32 * i;
        const f32x4 v = *(const f32x4*)(W + (size_t)(k0 + kk) * N + n0 + c4);
        const unsigned p0 = pk2(v[0], v[1]), p1 = pk2(v[2], v[3]);
        T[(c4 + 0) * 72 + kk] = (bf16_t)(p0 & 0xffffu); T[(c4 + 1) * 72 + kk] = (bf16_t)(p0 >> 16);
        T[(c4 + 2) * 72 + kk] = (bf16_t)(p1 & 0xffffu); T[(c4 + 3) * 72 + kk] = (bf16_t)(p1 >> 16); }
    __syncthreads();
    { const int n = tid >> 3, part = tid & 7;
      const u32x4 o = *(const LAS u32x4*)(lds + n * 144 + part * 16);
      const int row = rowmap(mode, n0 + n);
      *(u32x4*)(WT + (size_t)row * K + k0 + part * 8) = o; }
    __syncthreads();
}

DI void rowpass(const float* xin, const bf16_t* __restrict__ y, const float* __restrict__ gpost, float* xout,
                const float* __restrict__ gpre, bf16_t* __restrict__ hout, int nrows) {
    const int tid_ = otid(); const int lane = tid_ & 63, gw = blockIdx.x * 8 + (tid_ >> 6), ngw = gridDim.x * 8;
    for (int r = gw; r < nrows; r += ngw) {
        const float* xr = xin + (size_t)r * DM + lane * 4;
        f32x4 xv[8];
#pragma unroll
        for (int j = 0; j < 8; ++j) xv[j] = *(const f32x4*)(xr + j * 256);
        if (y) {
            const bf16_t* yr = y + (size_t)r * DM + lane * 4;
            f32x4 yv[8]; float ss = 0.f;
#pragma unroll
            for (int j = 0; j < 8; ++j) { const u32x2 u = *(const u32x2*)(yr + j * 256); yv[j] = (f32x4){bflo(u.x), bfhi(u.x), bflo(u.y), bfhi(u.y)};
                ss += yv[j][0] * yv[j][0] + yv[j][1] * yv[j][1] + yv[j][2] * yv[j][2] + yv[j][3] * yv[j][3]; }
            ss = wave_sum(ss);
            const float r1 = rsqrtf(ss * (1.f / DM) + EPS);
#pragma unroll
            for (int j = 0; j < 8; ++j) { const f32x4 gg = *(const f32x4*)(gpost + j * 256 + lane * 4); xv[j] += yv[j] * r1 * gg; }
        }
        if (xout) {
            float* xo = xout + (size_t)r * DM + lane * 4;
#pragma unroll
            for (int j = 0; j < 8; ++j) *(f32x4*)(xo + j * 256) = xv[j];
        }
        if (hout) {
            float ss = 0.f;
#pragma unroll
            for (int j = 0; j < 8; ++j) ss += xv[j][0] * xv[j][0] + xv[j][1] * xv[j][1] + xv[j][2] * xv[j][2] + xv[j][3] * xv[j][3];
            ss = wave_sum(ss);
            const float r2 = rsqrtf(ss * (1.f / DM) + EPS);
            bf16_t* ho = hout + (size_t)r * DM + lane * 4;
#pragma unroll
            for (int j = 0; j < 8; ++j) { const f32x4 gg = *(const f32x4*)(gpre + j * 256 + lane * 4); const f32x4 hv = xv[j] * r2 * gg;
                u32x2 w; w.x = pk2(hv[0], hv[1]); w.y = pk2(hv[2], hv[3]); *(u32x2*)(ho + j * 256) = w; }
        }
    }
}

DI void hgrn_combine(const bf16_t* __restrict__ OF, const bf16_t* __restrict__ OB, const bf16_t* __restrict__ PROJ, const float* __restrict__ gn, bf16_t* __restrict__ YB, int nrows) {
    const int tid_ = otid(); const int lane = tid_ & 63, gw = blockIdx.x * 8 + (tid_ >> 6), ngw = gridDim.x * 8;
    for (int r = gw; r < nrows; r += ngw) {
        float o[16]; float ss = 0.f;
#pragma unroll
        for (int hlf = 0; hlf < 2; ++hlf) {
            const u32x4 a = *(const u32x4*)(OF + (size_t)r * 1024 + lane * 16 + hlf * 8);
            const u32x4 b = *(const u32x4*)(OB + (size_t)r * 1024 + lane * 16 + hlf * 8);
#pragma unroll
            for (int k = 0; k < 4; ++k) { o[hlf * 8 + 2 * k] = bflo(a[k]) + bflo(b[k]); o[hlf * 8 + 2 * k + 1] = bfhi(a[k]) + bfhi(b[k]); }
        }
#pragma unroll
        for (int k = 0; k < 16; ++k) ss += o[k] * o[k];
        ss += __shfl_xor(ss, 1); ss += __shfl_xor(ss, 2); ss += __shfl_xor(ss, 4);
        const float rr = rsqrtf(ss * (1.f / 128.f) + EPS);
#pragma unroll
        for (int hlf = 0; hlf < 2; ++hlf) {
            const u32x4 gbv = *(const u32x4*)(PROJ + (size_t)r * NPROJ + 5120 + lane * 16 + hlf * 8);
            const f32x4 g0 = *(const f32x4*)(gn + (lane & 7) * 16 + hlf * 8), g1 = *(const f32x4*)(gn + (lane & 7) * 16 + hlf * 8 + 4);
            float v[8];
#pragma unroll
            for (int k = 0; k < 4; ++k) { v[2 * k] = siluf_(bflo(gbv[k])); v[2 * k + 1] = siluf_(bfhi(gbv[k])); }
            u32x4 w;
            w.x = pk2(o[hlf * 8 + 0] * rr * g0[0] * v[0], o[hlf * 8 + 1] * rr * g0[1] * v[1]);
            w.y = pk2(o[hlf * 8 + 2] * rr * g0[2] * v[2], o[hlf * 8 + 3] * rr * g0[3] * v[3]);
            w.z = pk2(o[hlf * 8 + 4] * rr * g1[0] * v[4], o[hlf * 8 + 5] * rr * g1[1] * v[5]);
            w.w = pk2(o[hlf * 8 + 6] * rr * g1[2] * v[6], o[hlf * 8 + 7] * rr * g1[3] * v[7]);
            *(u32x4*)(YB + (size_t)r * 1024 + lane * 16 + hlf * 8) = w;
        }
    }
}

constexpr int AT_KB = 64 * 272, AT_VB = 128 * 136;
constexpr int AT_K0 = 0, AT_V0 = 2 * AT_KB, AT_TAB = 2 * AT_KB + 2 * AT_VB, AT_EX = AT_TAB + 2048;
template <int KSTEPS, bool DIFF>
DI void attn_unit(LAS unsigned char* lds, const bf16_t* __restrict__ Q, int ldq, const bf16_t* __restrict__ Kg, int ldk,
                  const bf16_t* __restrict__ VT, size_t ldvt, int nkeys, int qpos0, const float* __restrict__ relb, float lam,
                  const float* __restrict__ gsub, bf16_t* __restrict__ O, int ldo, float c1) {
    const int tid = otid(), wid = tid >> 6, lane = tid & 63, ql = lane & 31, h = lane >> 5;
    const int c = DIFF ? (wid >> 2) : 0;
    const int qrow0 = DIFF ? (wid & 3) * 32 : wid * 32;
    LAS float* tab = (LAS float*)(lds + AT_TAB);
    if (DIFF) {
        if (tid < 257) { const int rel = tid - 128; const int n = rel < 0 ? -rel : rel;
            int b;
            if (n < 8) b = n; else { b = 8 + (int)(__logf((float)n * 0.125f) * (8.f / 2.772588722239781f) + 1e-4f); b = b > 15 ? 15 : b; }
            if (rel > 0) b += 16;
            tab[tid] = relb[b * 8] * LOG2E; }
    }
    bf16x8 qf[KSTEPS];
    { const bf16_t* qp = Q + (size_t)(qrow0 + ql) * ldq + c * 64 + h * 8;
#pragma unroll
      for (int ks = 0; ks < KSTEPS; ++ks) qf[ks] = *(const bf16x8*)(qp + ks * 16); }
    const int kkey0 = tid >> 4, kpart = tid & 15;
    const int ve0 = tid >> 3, vpart = tid & 7;
    u32x4 kreg[2], vreg[2];
    const bf16_t* kgp = Kg + (size_t)kkey0 * ldk + kpart * 8;
    const bf16_t* vgp = VT + (size_t)ve0 * ldvt + vpart * 8;
#define AT_LOAD(kt) do { kreg[0] = *(const u32x4*)(kgp + (size_t)((kt) * 64) * ldk); kreg[1] = *(const u32x4*)(kgp + (size_t)((kt) * 64 + 32) * ldk); \
        vreg[0] = *(const u32x4*)(vgp + (kt) * 64); vreg[1] = *(const u32x4*)(vgp + (size_t)64 * ldvt + (kt) * 64); } while (0)
#define AT_STORE(buf) do { *(LAS u32x4*)(lds + AT_K0 + (buf) * AT_KB + kkey0 * 272 + kpart * 16) = kreg[0]; *(LAS u32x4*)(lds + AT_K0 + (buf) * AT_KB + (kkey0 + 32) * 272 + kpart * 16) = kreg[1]; \
        *(LAS u32x2*)(lds + AT_V0 + (buf) * AT_VB + ve0 * 136 + vpart * 16) = (u32x2){vreg[0].x, vreg[0].y}; *(LAS u32x2*)(lds + AT_V0 + (buf) * AT_VB + ve0 * 136 + vpart * 16 + 8) = (u32x2){vreg[0].z, vreg[0].w}; \
        *(LAS u32x2*)(lds + AT_V0 + (buf) * AT_VB + (ve0 + 64) * 136 + vpart * 16) = (u32x2){vreg[1].x, vreg[1].y}; *(LAS u32x2*)(lds + AT_V0 + (buf) * AT_VB + (ve0 + 64) * 136 + vpart * 16 + 8) = (u32x2){vreg[1].z, vreg[1].w}; } while (0)
    AT_LOAD(0); AT_STORE(0);
    __syncthreads();
    const int nt = nkeys >> 6;
    f32x16 o[4];
#pragma unroll
    for (int et = 0; et < 4; ++et)
#pragma unroll
        for (int i = 0; i < 16; ++i) o[et][i] = 0.f;
    float m = -1e30f, l = 0.f, mthr = -1e30f;
    const int qpos = qpos0 + qrow0 + ql;
    for (int kt = 0; kt < nt; ++kt) {
        const int cur = kt & 1;
        if (DIFF) { if (kt + 1 < nt) AT_LOAD(kt + 1); }
        f32x16 s[2];
#pragma unroll
        for (int kt2 = 0; kt2 < 2; ++kt2) {
#pragma unroll
            for (int i = 0; i < 16; ++i) s[kt2][i] = 0.f;
#pragma unroll
            for (int ks = 0; ks < KSTEPS; ++ks) {
                const bf16x8 a = *(const LAS bf16x8*)(lds + AT_K0 + cur * AT_KB + (kt2 * 32 + ql) * 272 + (c * 64 + ks * 16 + h * 8) * 2);
                s[kt2] = MFMA32(a, qf[ks], s[kt2]);
            }
        }
        if (DIFF) {
            const int kbase = kt * 64;
            const int relmin = kbase - (qpos0 + qrow0 + 31), relmax = kbase + 63 - (qpos0 + qrow0);
            if (relmin >= 128 || relmax <= -128) {
                const float bc = relmin >= 128 ? tab[256] : tab[0];
#pragma unroll
                for (int kt2 = 0; kt2 < 2; ++kt2)
#pragma unroll
                    for (int i = 0; i < 16; ++i) s[kt2][i] = s[kt2][i] * c1 + bc;
            } else {
#pragma unroll
                for (int kt2 = 0; kt2 < 2; ++kt2)
#pragma unroll
                    for (int i = 0; i < 16; ++i) {
                        const int kpos = kbase + kt2 * 32 + (i & 3) + 8 * (i >> 2) + 4 * h;
                        int idx = kpos - qpos + 128; idx = idx < 0 ? 0 : (idx > 256 ? 256 : idx);
                        s[kt2][i] = s[kt2][i] * c1 + tab[idx];
                    }
            }
        } else {
#pragma unroll
            for (int kt2 = 0; kt2 < 2; ++kt2)
#pragma unroll
                for (int i = 0; i < 16; ++i) s[kt2][i] *= c1;
        }
        float mx = s[0][0];
#pragma unroll
        for (int kt2 = 0; kt2 < 2; ++kt2)
#pragma unroll
            for (int i = 0; i < 16; ++i) mx = fmaxf(mx, s[kt2][i]);
        mx = fmaxf(mx, __shfl_xor(mx, 32));
        if (__any(mx > mthr)) {
            const float mn = fmaxf(m, mx), alpha = fexp2(m - mn);
            l *= alpha; m = mn; mthr = mn + 8.f;
#pragma unroll
            for (int et = 0; et < 4; ++et)
#pragma unroll
                for (int i = 0; i < 16; ++i) o[et][i] *= alpha;
        }
        bf16x8 pf[2][2];
#pragma unroll
        for (int kt2 = 0; kt2 < 2; ++kt2) {
            float p[16];
#pragma unroll
            for (int i = 0; i < 16; ++i) { p[i] = fexp2(s[kt2][i] - m); l += p[i]; }
#pragma unroll
            for (int sp = 0; sp < 2; ++sp) {
                u32x4 w; w.x = pk2(p[8 * sp + 0], p[8 * sp + 1]); w.y = pk2(p[8 * sp + 2], p[8 * sp + 3]); w.z = pk2(p[8 * sp + 4], p[8 * sp + 5]); w.w = pk2(p[8 * sp + 6], p[8 * sp + 7]);
                pf[kt2][sp] = __builtin_bit_cast(bf16x8, w);
            }
        }
#pragma unroll
        for (int et = 0; et < 4; ++et)
#pragma unroll
            for (int kt2 = 0; kt2 < 2; ++kt2)
#pragma unroll
                for (int sp = 0; sp < 2; ++sp) {
                    const LAS unsigned char* vp = lds + AT_V0 + cur * AT_VB + (et * 32 + ql) * 136 + (kt2 * 32 + sp * 16 + 4 * h) * 2;
                    const s16x4 lo = *(const LAS s16x4*)vp, hi = *(const LAS s16x4*)(vp + 16);
                    const bf16x8 a = __builtin_shufflevector(lo, hi, 0, 1, 2, 3, 4, 5, 6, 7);
                    o[et] = MFMA32(a, pf[kt2][sp], o[et]);
                }
        if (kt + 1 < nt) { if (!DIFF) AT_LOAD(kt + 1); AT_STORE(cur ^ 1); }
        __syncthreads();
    }
#undef AT_LOAD
#undef AT_STORE
    l += __shfl_xor(l, 32);
    const float inv = 1.f / l;
    if (DIFF) {
        const float sc = (c == 0) ? inv : -lam * inv;
        LAS float* ex = (LAS float*)(lds + AT_EX) + (qrow0 + ql) * 132;
        if (c == 1) {
#pragma unroll
            for (int et = 0; et < 4; ++et)
#pragma unroll
                for (int ig = 0; ig < 4; ++ig)
                    *(LAS f32x4*)(ex + 32 * et + 8 * ig + 4 * h) = (f32x4){o[et][4 * ig] * sc, o[et][4 * ig + 1] * sc, o[et][4 * ig + 2] * sc, o[et][4 * ig + 3] * sc};
        }
        __syncthreads();
        if (c == 0) {
            float ss = 0.f;
#pragma unroll
            for (int et = 0; et < 4; ++et)
#pragma unroll
                for (int ig = 0; ig < 4; ++ig) {
                    const f32x4 b = *(const LAS f32x4*)(ex + 32 * et + 8 * ig + 4 * h);
#pragma unroll
                    for (int j = 0; j < 4; ++j) { const float v = o[et][4 * ig + j] * sc + b[j]; o[et][4 * ig + j] = v; ss += v * v; }
                }
            ss += __shfl_xor(ss, 32);
            const float rr = rsqrtf(ss * (1.f / 128.f) + EPS) * 0.8f;
            bf16_t* op = O + (size_t)(qrow0 + ql) * ldo;
#pragma unroll
            for (int et = 0; et < 4; ++et)
#pragma unroll
                for (int ig = 0; ig < 4; ++ig) {
                    const int e0 = 32 * et + 8 * ig + 4 * h;
                    const f32x4 gg = *(const f32x4*)(gsub + e0);
                    u32x2 w; w.x = pk2(o[et][4 * ig] * rr * gg[0], o[et][4 * ig + 1] * rr * gg[1]); w.y = pk2(o[et][4 * ig + 2] * rr * gg[2], o[et][4 * ig + 3] * rr * gg[3]);
                    *(u32x2*)(op + e0) = w;
                }
        }
        __syncthreads();
    } else {
        bf16_t* op = O + (size_t)(qrow0 + ql) * ldo;
#pragma unroll
        for (int et = 0; et < 4; ++et)
#pragma unroll
            for (int ig = 0; ig < 4; ++ig) {
                const int e0 = 32 * et + 8 * ig + 4 * h;
                u32x2 w; w.x = pk2(o[et][4 * ig] * inv, o[et][4 * ig + 1] * inv); w.y = pk2(o[et][4 * ig + 2] * inv, o[et][4 * ig + 3] * inv);
                *(u32x2*)(op + e0) = w;
            }
    }
}

constexpr int HG_QS = 0, HG_KS = 17408, HG_KST = 34816, HG_VTS = 53248, HG_AS = 71680, HG_SEG = 80896, HG_ER = 84992, HG_EL = 85504;
template <int DIR>
DI void hgrn_item(LAS unsigned char* lds, const bf16_t* __restrict__ PROJ, const bf16_t* __restrict__ VT, int row0, int S, int head,
                  const float* __restrict__ lblog, bf16_t* __restrict__ Oout) {
    const int tid = otid(), w = tid >> 6, lane = tid & 63, r16 = lane & 15, quad = lane >> 4;
    const int dp = lane, seg = w, d0 = 2 * dp;
    float lb0, lb1;
    { const float* lp = lblog + DIR * 2048 + head * 128 + d0;
      lb0 = frcp(1.f + fexp(lp[1024] - lp[0])); lb1 = frcp(1.f + fexp(lp[1025] - lp[1])); }
    const float SC = 0.08838834764831845f;
    const int nch = S >> 6;
    f32x4 st[8];
#pragma unroll
    for (int i = 0; i < 8; ++i) st[i] = (f32x4){0.f, 0.f, 0.f, 0.f};
    unsigned zq[8], qq[8]; u32x4 vt[2];
    const bf16_t* zbase = PROJ + 3072 + DIR * 1024 + head * 128 + d0;
    const bf16_t* qbase = PROJ + 2048 + head * 128 + d0;
    const bf16_t* vbase = VT + (size_t)(1024 + head * 128 + (tid >> 3)) * GR + (tid & 7) * 8;
#define HG_LOAD(trow) do { _Pragma("unroll") for (int i = 0; i < 8; ++i) { const size_t ro = (size_t)((trow) + seg * 8 + i) * NPROJ; zq[i] = *(const unsigned*)(zbase + ro); qq[i] = *(const unsigned*)(qbase + ro); } \
        vt[0] = *(const u32x4*)(vbase + (trow)); vt[1] = *(const u32x4*)(vbase + (size_t)64 * GR + (trow)); } while (0)
    { const int n0 = DIR ? nch - 1 : 0; HG_LOAD(row0 + n0 * 64); }
    for (int ci = 0; ci < nch; ++ci) {
        const int n = DIR ? nch - 1 - ci : ci;
        const int trow = row0 + n * 64;
        float bl0[8], bl1[8], k0[8], k1[8], q0[8], q1[8];
        float run0 = 0.f, run1 = 0.f;
#pragma unroll
        for (int ii = 0; ii < 8; ++ii) { const int i = DIR ? 7 - ii : ii;
            const float z0 = bflo(zq[i]), z1 = bfhi(zq[i]);
            const float s0 = sigmoidf_(z0), s1 = sigmoidf_(z1);
            const float f0 = lb0 + (1.f - lb0) * s0, f1 = lb1 + (1.f - lb1) * s1;
            run0 += __logf(f0); run1 += __logf(f1);
            bl0[i] = run0; bl1[i] = run1;
            k0[i] = (1.f - lb0) * (1.f - s0); k1[i] = (1.f - lb1) * (1.f - s1);
            q0[i] = bflo(qq[i]) * SC; q1[i] = bfhi(qq[i]) * SC; }
        *(LAS f32x2*)(lds + HG_SEG + (seg * 128 + d0) * 4) = (f32x2){run0, run1};
        *(LAS u32x4*)(lds + HG_VTS + (tid >> 3) * 144 + (tid & 7) * 16) = vt[0];
        *(LAS u32x4*)(lds + HG_VTS + ((tid >> 3) + 64) * 144 + (tid & 7) * 16) = vt[1];
        __syncthreads();
        {
            float off0 = 0.f, off1 = 0.f, ref0 = 0.f, ref1 = 0.f, tot0 = 0.f, tot1 = 0.f;
#pragma unroll
            for (int s2 = 0; s2 < 8; ++s2) { const f32x2 t = *(const LAS f32x2*)(lds + HG_SEG + (s2 * 128 + d0) * 4);
                tot0 += t[0]; tot1 += t[1];
                const bool before = DIR ? (s2 > seg) : (s2 < seg);
                const bool inref = DIR ? (s2 >= 4) : (s2 < 4);
                if (before) { off0 += t[0]; off1 += t[1]; }
                if (inref) { ref0 += t[0]; ref1 += t[1]; } }
            unsigned kt0[4], kt1[4];
            float ksv0[8], ksv1[8];
#pragma unroll
            for (int i = 0; i < 8; ++i) {
                const float b0 = off0 + bl0[i] - ref0, b1 = off1 + bl1[i] - ref1;
                const float qs0 = q0[i] * fexp(b0), qs1 = q1[i] * fexp(b1);
                ksv0[i] = k0[i] * fexp(-b0); ksv1[i] = k1[i] * fexp(-b1);
                *(LAS unsigned*)(lds + HG_QS + (seg * 8 + i) * 272 + d0 * 2) = pk2(qs0, qs1);
                *(LAS unsigned*)(lds + HG_KS + (seg * 8 + i) * 272 + d0 * 2) = pk2(ksv0[i], ksv1[i]);
            }
#pragma unroll
            for (int i = 0; i < 4; ++i) { kt0[i] = pk2(ksv0[2 * i], ksv0[2 * i + 1]); kt1[i] = pk2(ksv1[2 * i], ksv1[2 * i + 1]); }
            *(LAS u32x4*)(lds + HG_KST + d0 * 144 + seg * 16) = (u32x4){kt0[0], kt0[1], kt0[2], kt0[3]};
            *(LAS u32x4*)(lds + HG_KST + (d0 + 1) * 144 + seg * 16) = (u32x4){kt1[0], kt1[1], kt1[2], kt1[3]};
            if (seg == 0) {
                *(LAS f32x2*)(lds + HG_ER + d0 * 4) = (f32x2){fexp(ref0), fexp(ref1)};
                *(LAS f32x2*)(lds + HG_EL + d0 * 4) = (f32x2){fexp(tot0 - ref0), fexp(tot1 - ref1)};
            }
        }
        if (ci + 1 < nch) { const int n2 = DIR ? n - 1 : n + 1; HG_LOAD(row0 + n2 * 64); }
        __syncthreads();
        bf16x8 vfr[2];
#pragma unroll
        for (int ks2 = 0; ks2 < 2; ++ks2) vfr[ks2] = *(const LAS bf16x8*)(lds + HG_VTS + (16 * w + r16) * 144 + (ks2 * 32 + quad * 8) * 2);
        {
            const int stl = w & 3;
#pragma unroll
            for (int tti = 0; tti < 2; ++tti) { const int tt = 2 * (w >> 2) + tti;
                f32x4 acc = (f32x4){0.f, 0.f, 0.f, 0.f};
#pragma unroll
                for (int ks = 0; ks < 4; ++ks) {
                    const bf16x8 a = *(const LAS bf16x8*)(lds + HG_KS + (16 * stl + r16) * 272 + (32 * ks + 8 * quad) * 2);
                    const bf16x8 b = *(const LAS bf16x8*)(lds + HG_QS + (16 * tt + r16) * 272 + (32 * ks + 8 * quad) * 2);
                    acc = MFMA16(a, b, acc);
                }
                const int t = 16 * tt + r16, sb = 16 * stl + 4 * quad;
#pragma unroll
                for (int j = 0; j < 4; ++j) { const bool keep = DIR ? (sb + j >= t) : (t >= sb + j); acc[j] = keep ? acc[j] : 0.f; }
                *(LAS u32x2*)(lds + HG_AS + t * 144 + sb * 2) = (u32x2){pk2(acc[0], acc[1]), pk2(acc[2], acc[3])};
            }
        }
        f32x4 oacc[4];
#pragma unroll
        for (int tt = 0; tt < 4; ++tt) oacc[tt] = (f32x4){0.f, 0.f, 0.f, 0.f};
#pragma unroll
        for (int ks = 0; ks < 4; ++ks) {
            const f32x4 ea = *(const LAS f32x4*)(lds + HG_ER + (32 * ks + 4 * quad) * 4), eb = *(const LAS f32x4*)(lds + HG_ER + (32 * ks + 16 + 4 * quad) * 4);
            st[2 * ks] *= ea; st[2 * ks + 1] *= eb;
            const u32x4 bw = (u32x4){pk2(st[2 * ks][0], st[2 * ks][1]), pk2(st[2 * ks][2], st[2 * ks][3]), pk2(st[2 * ks + 1][0], st[2 * ks + 1][1]), pk2(st[2 * ks + 1][2], st[2 * ks + 1][3])};
            const bf16x8 bfrag = __builtin_bit_cast(bf16x8, bw);
#pragma unroll
            for (int tt = 0; tt < 4; ++tt) {
                const LAS unsigned char* qp = lds + HG_QS + (16 * tt + r16) * 272 + (32 * ks + 4 * quad) * 2;
                const s16x4 lo = *(const LAS s16x4*)qp, hi = *(const LAS s16x4*)(qp + 32);
                const bf16x8 a = __builtin_shufflevector(lo, hi, 0, 1, 2, 3, 4, 5, 6, 7);
                oacc[tt] = MFMA16(a, bfrag, oacc[tt]);
            }
        }
#pragma unroll
        for (int dt = 0; dt < 8; ++dt) {
            f32x4 acc = st[dt];
#pragma unroll
            for (int ks2 = 0; ks2 < 2; ++ks2) {
                const bf16x8 a = *(const LAS bf16x8*)(lds + HG_KST + (16 * dt + r16) * 144 + (32 * ks2 + 8 * quad) * 2);
                acc = MFMA16(a, vfr[ks2], acc);
            }
            const f32x4 el = *(const LAS f32x4*)(lds + HG_EL + (16 * dt + 4 * quad) * 4);
            st[dt] = acc * el;
        }
        __syncthreads();
#pragma unroll
        for (int tt = 0; tt < 4; ++tt) {
#pragma unroll
            for (int ks2 = 0; ks2 < 2; ++ks2) {
                const bf16x8 a = *(const LAS bf16x8*)(lds + HG_AS + (16 * tt + r16) * 144 + (32 * ks2 + 8 * quad) * 2);
                oacc[tt] = MFMA16(a, vfr[ks2], oacc[tt]);
            }
#pragma unroll
            for (int j = 0; j < 4; ++j) {
                const int t = 16 * tt + 4 * quad + j;
                Oout[(size_t)(trow + t) * 1024 + head * 128 + 16 * w + r16] = (bf16_t)(pk2(oacc[tt][j], 0.f) & 0xffffu);
            }
        }
    }
#undef HG_LOAD
    __syncthreads();
}

#define XB_TMO      128
#define XB_XCNT(j)  (256  + 64 * (j))
#define XB_XSUB(j)  (1280 + 64 * (j))
#define XB_XGEN(j)  (2304 + 64 * (j))
#define XB_TOP      3328
#define XB_TOPGEN   3392
#define XCD_BAR_WORDS 3456
#define XB_SPIN_CAP (1u << 24)
DI unsigned xb_ld(unsigned* p) { return __hip_atomic_load(p, __ATOMIC_RELAXED, __HIP_MEMORY_SCOPE_AGENT); }
DI unsigned xb_add(unsigned* p, unsigned v) { return __hip_atomic_fetch_add(p, v, __ATOMIC_RELAXED, __HIP_MEMORY_SCOPE_AGENT); }
DI unsigned xb_xcc_id() { return (unsigned)__builtin_amdgcn_s_getreg((3 << 11) | 20) & 0xFu; }
#define XB_SPIN(cond, bar) do { unsigned _sp = 0; while (cond) { __builtin_amdgcn_s_sleep(1); \
    if ((++_sp & 255u) == 0u) { if (xb_ld(&(bar)[XB_TMO])) break; if (_sp > XB_SPIN_CAP) { atomicAdd(&(bar)[XB_TMO], 1u); break; } } } } while (0)
struct XcdBarrier { unsigned* bar; unsigned x; volatile LAS unsigned* st; };
DI XcdBarrier xcd_barrier_post(unsigned* bar, volatile LAS unsigned* st) {
    XcdBarrier b; b.bar = bar; b.x = xb_xcc_id(); b.st = st;
    if (threadIdx.x == 0) (void)xb_add(&bar[XB_XCNT(b.x)], 1u);
    return b;
}
DI void xcd_barrier_complete(unsigned* bar, unsigned x, unsigned& nloc, unsigned& nx) {
    const unsigned G = gridDim.x * gridDim.y * gridDim.z;
    unsigned sum, cnt, mine, sp = 0u;
    for (;;) {
        sum = 0u; cnt = 0u; mine = 0u;
#pragma unroll
        for (unsigned j = 0; j < 16; ++j) { const unsigned c = xb_ld(&bar[XB_XCNT(j)]); sum += c; cnt += (c > 0u) ? 1u : 0u; mine = (j == x) ? c : mine; }
        if (sum == G) break;
        __builtin_amdgcn_s_sleep(1);
        if ((++sp & 255u) == 0u) { if (xb_ld(&bar[XB_TMO])) break; if (sp > XB_SPIN_CAP) { atomicAdd(&bar[XB_TMO], 1u); break; } }
    }
    nloc = mine > 0u ? mine : 1u; nx = cnt > 0u ? cnt : 1u;
}
DI void xcd_barrier(const XcdBarrier& b) {
    asm volatile("s_waitcnt vmcnt(0)" ::: "memory");
    __syncthreads();
    if (threadIdx.x == 0) {
        unsigned* bar = b.bar;
        __builtin_amdgcn_s_waitcnt(0);
        unsigned nloc = b.st[0], nx = b.st[1];
        if (nloc == 0u) { xcd_barrier_complete(bar, b.x, nloc, nx); b.st[0] = nloc; b.st[1] = nx; }
        const unsigned old = xb_add(&bar[XB_XSUB(b.x)], 1u);
        const unsigned gen = old / nloc;
        if (old + 1u == (gen + 1u) * nloc) {
            __builtin_amdgcn_fence(__ATOMIC_RELEASE, "agent");
            asm volatile("s_waitcnt vmcnt(0)" ::: "memory");
            const unsigned og = xb_add(&bar[XB_TOP], 1u);
            const unsigned tg = og / nx;
            if (og + 1u == (tg + 1u) * nx) xb_add(&bar[XB_TOPGEN], 1u);
            else XB_SPIN(xb_ld(&bar[XB_TOPGEN]) == tg, bar);
            __builtin_amdgcn_fence(__ATOMIC_ACQUIRE, "agent");
            xb_add(&bar[XB_XGEN(b.x)], 1u);
            asm volatile("s_waitcnt vmcnt(0)" ::: "memory");
        } else {
            XB_SPIN(xb_ld(&bar[XB_XGEN(b.x)]) == gen, bar);
            __builtin_amdgcn_fence(__ATOMIC_ACQUIRE, "agent");
            asm volatile("s_waitcnt vmcnt(0)" ::: "memory");
        }
    }
    __syncthreads();
}

typedef const __attribute__((address_space(4))) Params* CParams;
DI void run_step(CParams pp, int s, LAS unsigned char* lds) {
    asm volatile("" : "+s"(pp));
    const __attribute__((address_space(4))) Params& p = *pp;
    unsigned char* ws = p.ws;
    bf16_t* WIN = (bf16_t*)(ws + WS_WIN); bf16_t* WA = (bf16_t*)(ws + WS_WA); bf16_t* WB = (bf16_t*)(ws + WS_WB); bf16_t* WOUT = (bf16_t*)(ws + WS_WOUT);
    bf16_t* WQ = (bf16_t*)(ws + WS_WQ); bf16_t* WKV = (bf16_t*)(ws + WS_WKV); bf16_t* WO = (bf16_t*)(ws + WS_WO); bf16_t* WGU = (bf16_t*)(ws + WS_WGU); bf16_t* WD = (bf16_t*)(ws + WS_WD);
    bf16_t* MN = (bf16_t*)(ws + WS_MN); bf16_t* KX = (bf16_t*)(ws + WS_KX); bf16_t* VXT = (bf16_t*)(ws + WS_VXT);
    unsigned* CTR = (unsigned*)(ws + WS_CTR);
    bf16_t* H = (bf16_t*)(ws + WS_H); bf16_t* PROJ = (bf16_t*)(ws + WS_PROJ); bf16_t* ACT = PROJ; bf16_t* VT = (bf16_t*)(ws + WS_VT);
    bf16_t* YA = (bf16_t*)(ws + WS_YA); bf16_t* YB = (bf16_t*)(ws + WS_YB); bf16_t* QX = YA; bf16_t* OX = YB;
    bf16_t* OF = (bf16_t*)(ws + WS_OF); bf16_t* OB = (bf16_t*)(ws + WS_OB); bf16_t* Y = (bf16_t*)(ws + WS_Y);
    const int tid = otid();
    if (s == 0) {
        if (blockIdx.x == 0) { if (tid < 64) CTR[tid] = 0u; unsigned* BARW = (unsigned*)(ws + WS_BAR); for (int i = tid; i < XCD_BAR_WORDS; i += 512) BARW[i] = 0u; }
        const int T0 = 32 * 192, T1 = 16 * 32, T2 = 16 * 32, T3 = 32 * 32, T4 = 32 * 8, T5 = 32 * 16, T6 = 8 * 32, T7 = 32 * 176, T8 = 88 * 32;
        const int TT = T0 + T1 + T2 + T3 + T4 + T5 + T6 + T7 + T8;
        for (int it = blockIdx.x; it < TT; it += gridDim.x) {
            int r = it;
            if (r < T0) { transpose_tile(p.in[7], 2048, 12288, WIN, 1, r, lds); continue; } r -= T0;
            if (r < T1) { transpose_tile(p.in[15], 1024, 2048, WA, 0, r, lds); continue; } r -= T1;
            if (r < T2) { transpose_tile(p.in[16], 1024, 2048, WB, 0, r, lds); continue; } r -= T2;
            if (r < T3) { transpose_tile(p.in[17], 2048, 2048, WOUT, 0, r, lds); continue; } r -= T3;
            if (r < T4) { transpose_tile(p.in[21], 2048, 512, WQ, 0, r, lds); continue; } r -= T4;
            if (r < T5) { transpose_tile(p.in[22], 2048, 1024, WKV, 0, r, lds); continue; } r -= T5;
            if (r < T6) { transpose_tile(p.in[23], 512, 2048, WO, 0, r, lds); continue; } r -= T6;
            if (r < T7) { transpose_tile(p.in[26], 2048, 11264, WGU, 2, r, lds); continue; } r -= T7;
            transpose_tile(p.in[27], 5632, 2048, WD, 0, r, lds);
        }
        rowpass(p.in[2], nullptr, nullptr, nullptr, p.in[20], MN, 4096);
        rowpass(p.in[3], nullptr, nullptr, nullptr, p.in[20], MN + (size_t)4096 * DM, 1024);
        return;
    }
    const int g = (s - 1) / NPH, ph = (s - 1) % NPH;
    const bool isP = g < 2;
    const int S = isP ? 2048 : 8192, nseq = GR / S, seqbase = isP ? g * 8 : 16 + (g - 2) * 2;
    const float* xin = isP ? p.in[0] + (size_t)g * GR * DM : p.in[1] + (size_t)(g - 2) * GR * DM;
    float* xo = p.out + (size_t)g * GR * DM;
#ifndef PHMASK
#define PHMASK 0xFFFF
#endif
    if (!((PHMASK >> ph) & 1)) return;
    switch (ph) {
    case 0: rowpass(xin, nullptr, nullptr, nullptr, p.in[6], H, GR); break;
    case 1: {
        { pg8::EpiBf16<1> E; E.O = PROJ; E.ldc = NPROJ; E.bias = p.in[8]; run_gemm(lds, H, WIN, GR, NPROJ, DM, E); }
        { pg8::EpiBf16<0> E; E.O = VT; E.ldc = GR; E.bias = nullptr; run_gemm(lds, WIN + (size_t)NPROJ * DM, H, 2048, GR, DM, E); }
        if (g == 0) {
            { pg8::EpiBf16<0> E; E.O = KX; E.ldc = 512; E.bias = nullptr; run_gemm(lds, MN, WKV, NMEMROWS, 512, DM, E, 64); }
            { pg8::EpiBf16<0> E; E.O = VXT; E.ldc = NMEMROWS; E.bias = nullptr; run_gemm(lds, WKV + (size_t)512 * DM, MN, 512, NMEMROWS, DM, E, 128); }
        }
    } break;
    case 2: {
        const float lam = fexp(wave_sum(p.in[9][tid & 63] * p.in[10][tid & 63])) - fexp(wave_sum(p.in[11][tid & 63] * p.in[12][tid & 63])) + 0.2f;
        const int n_hg = nseq * 16, nqb = S / 128, n_at = nseq * 8 * nqb, total = n_hg + n_at;
        LAS int* sitem = (LAS int*)(lds + LDS_BYTES - 48);
        for (;;) {
            if (tid == 0) *sitem = (int)atomicAdd(&CTR[g], 1u);
            __syncthreads();
            const int item = *sitem;
            __syncthreads();
            if (item >= total) break;
            if (item < n_hg) {
                const int sl = item >> 4, head = (item >> 1) & 7, dir = item & 1;
                if (dir == 0) hgrn_item<0>(lds, PROJ, VT, sl * S, S, head, p.in[5], OF);
                else hgrn_item<1>(lds, PROJ, VT, sl * S, S, head, p.in[5], OB);
            } else {
                const int a = item - n_hg, sl = a / (8 * nqb), rem = a - sl * 8 * nqb, head = rem / nqb, qb = rem - head * nqb;
                attn_unit<4, true>(lds, PROJ + (size_t)(sl * S + qb * 128) * NPROJ + head * 128, NPROJ,
                                   PROJ + (size_t)(sl * S) * NPROJ + 1024 + head * 128, NPROJ,
                                   VT + (size_t)(head * 128) * GR + sl * S, (size_t)GR, S, qb * 128, p.in[4] + head, lam, p.in[13],
                                   YA + (size_t)(sl * S + qb * 128) * 1024 + head * 128, 1024, 0.125f * LOG2E);
            }
        }
    } break;
    case 3: hgrn_combine(OF, OB, PROJ, p.in[14], YB, GR); break;
    case 4: {
        { pg8::EpiGate<false> E; E.O = H; E.ldc = DM; E.Gt = PROJ + 6144; E.ldg = NPROJ; run_gemm(lds, YA, WA, GR, DM, 1024, E); }
        { pg8::EpiGate<true> E; E.O = H; E.ldc = DM; E.Gt = PROJ + 8192; E.ldg = NPROJ; run_gemm(lds, YB, WB, GR, DM, 1024, E); }
    } break;
    case 5: { pg8::EpiBf16<0> E; E.O = Y; E.ldc = DM; E.bias = nullptr; run_gemm(lds, H, WOUT, GR, DM, DM, E); } break;
    case 6: rowpass(xin, Y, p.in[18], xo, p.in[19], H, GR); break;
    case 7: { pg8::EpiBf16<0> E; E.O = QX; E.ldc = 512; E.bias = nullptr; run_gemm(lds, H, WQ, GR, 512, DM, E); } break;
    case 8: {
        for (int u = blockIdx.x; u < (GR / 256) * 4; u += gridDim.x) {
            const int head = u & 3, qb = u >> 2, l0 = qb * 256, memseq = seqbase + l0 / S;
            attn_unit<8, false>(lds, QX + (size_t)l0 * 512 + head * 128, 512, KX + (size_t)(memseq * 256) * 512 + head * 128, 512,
                                VXT + (size_t)(head * 128) * NMEMROWS + memseq * 256, (size_t)NMEMROWS, 256, 0, nullptr, 0.f, nullptr,
                                OX + (size_t)l0 * 512 + head * 128, 512, 0.08838834764831845f * LOG2E);
        }
    } break;
    case 9: { pg8::EpiBf16<0> E; E.O = Y; E.ldc = DM; E.bias = nullptr; run_gemm(lds, OX, WO, GR, DM, 512, E); } break;
    case 10: rowpass(xo, Y, p.in[24], xo, p.in[25], H, GR); break;
    case 11: { pg8::EpiSwiGLU E; E.O = ACT; E.ldc = DFF; run_gemm(lds, H, WGU, GR, 2 * DFF, DM, E); } break;
    case 12: { pg8::EpiBf16<0> E; E.O = Y; E.ldc = DM; E.bias = nullptr; run_gemm(lds, ACT, WD, GR, DM, DFF, E); } break;
    case 13: rowpass(xo, Y, p.in[28], xo, nullptr, nullptr, GR); break;
    }
}

__global__ void __launch_bounds__(512, 2) mk_fwd(Params p) {
    extern __shared__ __attribute__((aligned(16))) unsigned char shm[];
    LAS unsigned char* lds = (LAS unsigned char*)shm;
    CParams pp = (CParams)__builtin_amdgcn_kernarg_segment_ptr();
    volatile LAS unsigned* xst = (volatile LAS unsigned*)(lds + LDS_BYTES - 32);
    if (threadIdx.x == 0) { xst[0] = 0u; xst[1] = 0u; }
    __syncthreads();
    XcdBarrier xb; xb.bar = (unsigned*)(p.ws + WS_BAR); xb.x = 0; xb.st = xst;
    for (int s = p.lo; s < p.hi; ++s) {
        run_step(pp, s, lds);
        if (s + 1 < p.hi) {
            if (s == 0) { __syncthreads(); cg::this_grid().sync(); xb = xcd_barrier_post((unsigned*)(p.ws + WS_BAR), xst); }
            else xcd_barrier(xb);
        }
    }
}

extern "C" void kernel_launch(void* const* d_in, const int* in_sizes, int n_in, void* d_out, int out_size, void* d_ws, size_t ws_size, hipStream_t stream) {
    static int grid = 0;
    if (grid == 0) {
        if (n_in != 29 || ws_size < WS_END) { fprintf(stderr, "kernel_launch: unexpected n_in %d or ws_size %zu (< %zu)\n", n_in, ws_size, (size_t)WS_END); grid = -1; return; }
        int dev = 0, cus = 0, per_cu = 0;
        (void)hipGetDevice(&dev);
        (void)hipDeviceGetAttribute(&cus, hipDeviceAttributeMultiprocessorCount, dev);
        if (hipFuncSetAttribute((const void*)mk_fwd, hipFuncAttributeMaxDynamicSharedMemorySize, LDS_BYTES) != hipSuccess) { fprintf(stderr, "kernel_launch: hipFuncSetAttribute failed\n"); grid = -1; return; }
        if (hipOccupancyMaxActiveBlocksPerMultiprocessor(&per_cu, (const void*)mk_fwd, 512, LDS_BYTES) != hipSuccess || per_cu < 1) { fprintf(stderr, "kernel_launch: occupancy query %d\n", per_cu); per_cu = 1; (void)hipGetLastError(); }
        grid = cus * 1;
    }
    if (grid < 0) return;
    Params p{};
    for (int i = 0; i < 29; ++i) p.in[i] = (const float*)d_in[i];
    p.out = (float*)d_out; p.ws = (unsigned char*)d_ws;
#if MK_COOP
    p.lo = 0; p.hi = NSTEPS;
    void* args[] = {&p};
    hipError_t e = hipLaunchCooperativeKernel((const void*)mk_fwd, dim3(grid), dim3(512), args, LDS_BYTES, stream);
    if (e != hipSuccess) fprintf(stderr, "cooperative launch failed: %s (grid %d)\n", hipGetErrorString(e), grid);
#else
    for (int s = 0; s < NSTEPS; ++s) { p.lo = s; p.hi = s + 1; hipLaunchKernelGGL(mk_fwd, dim3(grid), dim3(512), LDS_BYTES, stream, p); }
#endif
}
#ifdef RES_TEST
#define TK(name, body) __global__ void __launch_bounds__(512, 2) name(Params p) { extern __shared__ __attribute__((aligned(16))) unsigned char shm[]; LAS unsigned char* lds = (LAS unsigned char*)shm; body }
TK(t_step0, run_step((CParams)__builtin_amdgcn_kernarg_segment_ptr(), 0, lds);)
TK(t_ph0, run_step((CParams)__builtin_amdgcn_kernarg_segment_ptr(), 1 + 0, lds);)
TK(t_ph1, run_step((CParams)__builtin_amdgcn_kernarg_segment_ptr(), 1 + 1, lds);)
TK(t_ph2, run_step((CParams)__builtin_amdgcn_kernarg_segment_ptr(), 1 + 2, lds);)
TK(t_ph3, run_step((CParams)__builtin_amdgcn_kernarg_segment_ptr(), 1 + 3, lds);)
TK(t_ph4, run_step((CParams)__builtin_amdgcn_kernarg_segment_ptr(), 1 + 4, lds);)
TK(t_ph5, run_step((CParams)__builtin_amdgcn_kernarg_segment_ptr(), 1 + 5, lds);)
TK(t_ph6, run_step((CParams)__builtin_amdgcn_kernarg_segment_ptr(), 1 + 6, lds);)
TK(t_ph8, run_step((CParams)__builtin_amdgcn_kernarg_segment_ptr(), 1 + 8, lds);)
TK(t_ph11, run_step((CParams)__builtin_amdgcn_kernarg_segment_ptr(), 1 + 11, lds);)
TK(t_hg0, hgrn_item<0>(lds, (const bf16_t*)p.ws, (const bf16_t*)p.ws, p.lo, p.hi, 1, p.in[5], (bf16_t*)p.out);)
TK(t_hg1, hgrn_item<1>(lds, (const bf16_t*)p.ws, (const bf16_t*)p.ws, p.lo, p.hi, 1, p.in[5], (bf16_t*)p.out);)
TK(t_at, (attn_unit<4, true>(lds, (const bf16_t*)p.ws, NPROJ, (const bf16_t*)p.ws, NPROJ, (const bf16_t*)p.ws, (size_t)GR, p.hi, p.lo, p.in[4], 0.3f, p.in[13], (bf16_t*)p.out, 1024, 0.18f));)
TK(t_xat, (attn_unit<8, false>(lds, (const bf16_t*)p.ws, NPROJ, (const bf16_t*)p.ws, NPROJ, (const bf16_t*)p.ws, (size_t)GR, p.hi, p.lo, p.in[4], 0.3f, p.in[13], (bf16_t*)p.out, 1024, 0.18f));)
#endif
```

```cpp
#include <hip/hip_runtime.h>
#include <hip/hip_cooperative_groups.h>
#include <cstdio>
#include <cstdint>
namespace cg = cooperative_groups;

#ifndef PROBE_MASK
#define PROBE_MASK 0
#endif
#ifndef PROBE_GMASK
#define PROBE_GMASK 0xF
#endif
#ifndef PROBE_ITEM
#define PROBE_ITEM 0
#endif
#ifndef MK_COOP
#define MK_COOP 1
#endif

#define LAS __attribute__((address_space(3)))
#define DI __device__ __forceinline__
typedef unsigned short bf16_t;
typedef short bf16x8 __attribute__((ext_vector_type(8)));
typedef short s16x4 __attribute__((ext_vector_type(4)));
typedef float f32x4 __attribute__((ext_vector_type(4)));
typedef float f32x2 __attribute__((ext_vector_type(2)));
typedef float f32x16 __attribute__((ext_vector_type(16)));
typedef unsigned u32x4 __attribute__((ext_vector_type(4)));
typedef unsigned u32x2 __attribute__((ext_vector_type(2)));

constexpr int DM = 2048, NPROJ = 10240, DFF = 5632;
constexpr int GR = 16384;
constexpr int NGROUP = 4;
constexpr int NMEMROWS = 5120;
constexpr float EPS = 1e-6f;
constexpr float LOG2E = 1.4426950408889634f;
constexpr int LDS_BYTES = 147456;
constexpr int NPH = 11;
constexpr int NSTEPS = 1 + NGROUP * NPH + 1;

constexpr size_t WS_WIN = 0;
constexpr size_t WS_WA = WS_WIN + (size_t)12288 * 2048 * 2;
constexpr size_t WS_WB = WS_WA + (size_t)2048 * 1024 * 2;
constexpr size_t WS_WOUT = WS_WB + (size_t)2048 * 1024 * 2;
constexpr size_t WS_WQ = WS_WOUT + (size_t)2048 * 2048 * 2;
constexpr size_t WS_WKV = WS_WQ + (size_t)512 * 2048 * 2;
constexpr size_t WS_WO = WS_WKV + (size_t)1024 * 2048 * 2;
constexpr size_t WS_WGU = WS_WO + (size_t)2048 * 512 * 2;
constexpr size_t WS_WD = WS_WGU + (size_t)11264 * 2048 * 2;
constexpr size_t WS_MN = WS_WD + (size_t)2048 * 5632 * 2;
constexpr size_t WS_KX = WS_MN + (size_t)NMEMROWS * 2048 * 2;
constexpr size_t WS_VXT = WS_KX + (size_t)NMEMROWS * 512 * 2;
constexpr size_t WS_CTR = WS_VXT + (size_t)NMEMROWS * 512 * 2;
constexpr size_t WS_BAR = WS_CTR + 1024;
constexpr size_t WS_H = WS_CTR + 16384;
constexpr size_t WS_PROJ = WS_H + (size_t)GR * 2048 * 2;
constexpr size_t WS_VT = WS_PROJ + (size_t)GR * NPROJ * 2;
constexpr size_t WS_YA = WS_VT + (size_t)2048 * GR * 2;
constexpr size_t WS_YB = WS_YA + (size_t)GR * 1024 * 2;
constexpr size_t WS_OF = WS_YB + (size_t)GR * 1024 * 2;
constexpr size_t WS_OB = WS_OF + (size_t)GR * 1024 * 2;
constexpr size_t WS_Y = WS_OB + (size_t)GR * 1024 * 2;
constexpr size_t WS_XR = WS_Y + (size_t)GR * 2048 * 2;
constexpr size_t WS_H2 = WS_XR + (size_t)GR * 2048 * 2;
constexpr size_t WS_END = WS_H2 + (size_t)GR * 2048 * 2;

struct Params {
    const float* in[29];
    float* out;
    unsigned char* ws;
    int lo, hi;
};

typedef const __attribute__((address_space(4))) Params* CParams;
DI float bf2f(bf16_t b) { return __uint_as_float(((unsigned)b) << 16); }
DI float bflo(unsigned u) { return __uint_as_float(u << 16); }
DI float bfhi(unsigned u) { return __uint_as_float(u & 0xffff0000u); }
typedef __bf16 bfx2_t __attribute__((ext_vector_type(2)));
DI unsigned pk2(float lo, float hi) { const f32x2 v = {lo, hi}; const bfx2_t b = __builtin_convertvector(v, bfx2_t); return __builtin_bit_cast(unsigned, b); }
DI float fexp2(float x) { return __builtin_amdgcn_exp2f(x); }
DI float fexp(float x) { return __builtin_amdgcn_exp2f(x * LOG2E); }
DI float frcp(float x) { return __builtin_amdgcn_rcpf(x); }
DI float sigmoidf_(float x) { return frcp(1.f + fexp(-x)); }
DI float siluf_(float x) { return x * frcp(1.f + fexp(-x)); }
DI float wave_sum(float v) {
#pragma unroll
    for (int o = 1; o < 64; o <<= 1) v += __shfl_xor(v, o);
    return v;
}
DI int otid() { int t = threadIdx.x; asm volatile("" : "+v"(t)); return t; }
#define MFMA16(a, b, c) __builtin_amdgcn_mfma_f32_16x16x32_bf16((a), (b), (c), 0, 0, 0)
#define MFMA32(a, b, c) __builtin_amdgcn_mfma_f32_32x32x16_bf16((a), (b), (c), 0, 0, 0)

namespace pg8 {
constexpr int BM = 256, BK = 64, HALF = 128, HTB = HALF * BK * 2, STAGE_BYTES = 8 * HTB, NXCD = 8, WGM = 8;
__host__ __device__ __forceinline__ int lds_byte(int r, int c) { const int st = (r >> 4) * 2 + (c >> 5), rr = r & 15, cc = c & 31, ob = rr * 64 + cc * 2; return st * 1024 + (ob ^ (((ob >> 9) & 1) << 5)); }
__host__ __device__ __forceinline__ void stage_rc(int b, int& R, int& C) { const int st = b / 1024, sb = b % 1024, swz = sb ^ (((sb >> 9) & 1) << 5); R = (st >> 1) * 16 + swz / 64; C = (st & 1) * 32 + (swz % 64) / 2; }
__host__ __device__ __forceinline__ int perm32(int rho) { const int n = rho >> 4, i = rho & 15; return 8 * (i >> 2) + 4 * n + (i & 3); }
struct Unit { int pm, pn; };
struct Gemm { const bf16_t* A; const bf16_t* Bt; int M, N, K; };
struct StaticOrder {
    int nM, nN, nwg, G, c;
    __device__ void init(int M, int N, int G_, int c_) { nM = M / BM; nN = N / BM; nwg = nM * nN; G = G_; c = c_; }
    __device__ bool next(int i, Unit& u) const {
        const long L = (long)i * G + c; if (L >= nwg) return false;
        int wgid = (int)L; { const int q = nwg / NXCD, r = nwg % NXCD, xcd = wgid % NXCD, off = wgid / NXCD; wgid = (xcd < r ? xcd * (q + 1) : r * (q + 1) + (xcd - r) * q) + off; }
        const int nig = WGM * nN, gid = wgid / nig, fm = gid * WGM, gsz = (nM - fm) < WGM ? (nM - fm) : WGM;
        u.pm = fm + ((wgid % nig) % gsz); u.pn = (wgid % nig) / gsz; return true;
    }
};

template <class Epi>
__device__ __forceinline__ void gemm_phase(LAS unsigned char* lds, const Gemm g, const StaticOrder& S, const Epi& E) {
    const int tid = otid(), wid = __builtin_amdgcn_readfirstlane(tid >> 6), lane = tid & 63, wr = wid >> 2, wc = wid & 3, fr = lane & 15, fq = lane >> 4;
    const int K = g.K, nt = K / BK;
    unsigned voffA[2], voffB[2];
#pragma unroll
    for (int i = 0; i < 2; ++i) { int R, C; stage_rc(tid * 16 + i * 8192, R, C); const int Rb = (R & ~31) + perm32(R & 31);
        voffA[i] = (unsigned)(R * K + C) * 2u; voffB[i] = (unsigned)(Rb * K + C) * 2u; }
    const size_t kstep = (size_t)(BK * 2);
    const size_t hstep = (size_t)HALF * K * 2;
    const size_t tstep = 2 * hstep;
    const unsigned ldsw = (unsigned)wid * 1024u;
    const int aoff = lds_byte(wr * 64 + fr, fq * 8), boff = lds_byte(wc * 32 + fr, fq * 8);
#define PG8_SA(b, h) (((b) * 2 + (h)) * HTB)
#define PG8_SB(b, h) ((4 + (b) * 2 + (h)) * HTB)
#define PG8_STAGE(bufoff, gbase, voff) do { _Pragma("unroll") for (int _i = 0; _i < 2; ++_i) \
        __builtin_amdgcn_global_load_lds((const unsigned*)((const char*)(gbase) + (voff)[_i]), (LAS unsigned*)(lds + (bufoff) + ldsw + _i * 8192), 16, 0, 0); } while (0)
#define PG8_LDA(dst, b, h) do { _Pragma("unroll") for (int m = 0; m < 4; ++m) _Pragma("unroll") for (int k = 0; k < 2; ++k) dst[m][k] = *(const LAS bf16x8*)(lds + PG8_SA(b, h) + aoff + m * 2048 + k * 1024); } while (0)
#define PG8_LDB(dst, b, h) do { _Pragma("unroll") for (int n = 0; n < 2; ++n) _Pragma("unroll") for (int k = 0; k < 2; ++k) dst[n][k] = *(const LAS bf16x8*)(lds + PG8_SB(b, h) + boff + n * 2048 + k * 1024); } while (0)
#define PG8_MMA(ai, bj, At, Bt) do { __builtin_amdgcn_s_setprio(1); _Pragma("unroll") for (int m = 0; m < 4; ++m) _Pragma("unroll") for (int n = 0; n < 2; ++n) _Pragma("unroll") for (int k = 0; k < 2; ++k) \
        acc[ai][bj][m][n] = __builtin_amdgcn_mfma_f32_16x16x32_bf16(Bt[n][k], At[m][k], acc[ai][bj][m][n], 0, 0, 0); __builtin_amdgcn_s_setprio(0); } while (0)
#define PG8_WAIT_V(n) asm volatile("s_waitcnt vmcnt(" #n ")" ::: "memory")
#define PG8_WAIT_L(n) asm volatile("s_waitcnt lgkmcnt(" #n ")" ::: "memory")
#define PG8_BAR __builtin_amdgcn_s_barrier()
#define PG8_SCHED __builtin_amdgcn_sched_barrier(0)
    Unit cur, nxt; int ui = 0;
    if (!S.next(0, cur)) return;
    f32x4 acc[2][2][4][2];
#pragma unroll
    for (int a = 0; a < 2; ++a)
#pragma unroll
        for (int b = 0; b < 2; ++b)
#pragma unroll
            for (int m = 0; m < 4; ++m)
#pragma unroll
                for (int n = 0; n < 2; ++n) acc[a][b][m][n] = (f32x4){0.f, 0.f, 0.f, 0.f};
    bf16x8 At[4][2], B0[2][2], B1[2][2];
    const char* cA = (const char*)g.A + (size_t)cur.pm * tstep; const char* cB = (const char*)g.Bt + (size_t)cur.pn * tstep;
    PG8_STAGE(PG8_SB(0, 0), cB, voffB); PG8_STAGE(PG8_SA(0, 0), cA, voffA); PG8_STAGE(PG8_SB(0, 1), cB + hstep, voffB); PG8_STAGE(PG8_SA(0, 1), cA + hstep, voffA);
    if (wr == 1) PG8_BAR;
    PG8_WAIT_V(4); PG8_BAR;
    PG8_STAGE(PG8_SB(1, 0), cB + kstep, voffB); PG8_STAGE(PG8_SA(1, 0), cA + kstep, voffA); PG8_STAGE(PG8_SB(1, 1), cB + hstep + kstep, voffB);
    PG8_WAIT_V(6); PG8_BAR;
    for (;;) {
        const bool has_next = S.next(ui + 1, nxt);
        const char* nA = has_next ? (const char*)g.A + (size_t)nxt.pm * tstep : cA; const char* nB = has_next ? (const char*)g.Bt + (size_t)nxt.pn * tstep : cB;
        for (int t = 0; t < nt; t += 2) {
            const bool last = (t == nt - 2);
            const char* a1 = cA + (size_t)(t + 1) * kstep;
            const char* a2 = last ? nA : cA + (size_t)(t + 2) * kstep; const char* b2 = last ? nB : cB + (size_t)(t + 2) * kstep;
            const char* a3 = a2 + kstep; const char* b3 = b2 + kstep;
            PG8_LDB(B0, 0, 0); PG8_SCHED; PG8_LDA(At, 0, 0); PG8_STAGE(PG8_SA(1, 1), a1 + hstep, voffA);
            PG8_WAIT_L(8); PG8_BAR; PG8_WAIT_L(0); PG8_MMA(0, 0, At, B0); PG8_BAR; PG8_SCHED;
            PG8_LDB(B1, 0, 1); PG8_STAGE(PG8_SB(0, 0), b2, voffB);
            PG8_BAR; PG8_WAIT_L(0); PG8_MMA(0, 1, At, B1); PG8_BAR;
            PG8_LDA(At, 0, 1); PG8_STAGE(PG8_SA(0, 0), a2, voffA);
            PG8_BAR; PG8_WAIT_L(0); PG8_MMA(1, 0, At, B0); PG8_BAR; PG8_SCHED;
            PG8_STAGE(PG8_SB(0, 1), b2 + hstep, voffB);
            PG8_WAIT_V(6); PG8_BAR; PG8_MMA(1, 1, At, B1); PG8_BAR;
            PG8_LDB(B0, 1, 0); PG8_SCHED; PG8_LDA(At, 1, 0); PG8_STAGE(PG8_SA(0, 1), a2 + hstep, voffA);
            PG8_WAIT_L(8); PG8_BAR; PG8_WAIT_L(0); PG8_MMA(0, 0, At, B0); PG8_BAR; PG8_SCHED;
            PG8_LDB(B1, 1, 1); PG8_STAGE(PG8_SB(1, 0), b3, voffB);
            PG8_BAR; PG8_WAIT_L(0); PG8_MMA(0, 1, At, B1); PG8_BAR;
            PG8_LDA(At, 1, 1); PG8_STAGE(PG8_SA(1, 0), a3, voffA);
            PG8_BAR; PG8_WAIT_L(0); PG8_MMA(1, 0, At, B0); PG8_BAR; PG8_SCHED;
            PG8_STAGE(PG8_SB(1, 1), b3 + hstep, voffB);
            PG8_WAIT_V(6); PG8_BAR; PG8_MMA(1, 1, At, B1); PG8_BAR;
        }
        E(acc, cur, wr, wc, fr, fq);
        if (!has_next) break;
#pragma unroll
        for (int a = 0; a < 2; ++a)
#pragma unroll
            for (int b = 0; b < 2; ++b)
#pragma unroll
                for (int m = 0; m < 4; ++m)
#pragma unroll
                    for (int n = 0; n < 2; ++n) acc[a][b][m][n] = (f32x4){0.f, 0.f, 0.f, 0.f};
        cur = nxt; cA = nA; cB = nB; ++ui;
    }
    PG8_WAIT_V(0);
    if (wr == 0) PG8_BAR;
    PG8_BAR;
#undef PG8_SA
#undef PG8_SB
#undef PG8_STAGE
#undef PG8_LDA
#undef PG8_LDB
#undef PG8_MMA
#undef PG8_WAIT_V
#undef PG8_WAIT_L
#undef PG8_BAR
#undef PG8_SCHED
}

template <int MODE> struct EpiBf16 {
    bf16_t* O; int ldc; const float* bias;
    DI void operator()(const f32x4 (&acc)[2][2][4][2], const Unit& u, int wr, int wc, int fr, int fq) const {
        const int row0 = u.pm * BM + wr * 64 + fr, col0 = u.pn * BM + wc * 32 + 8 * fq;
        const bool gate = (MODE == 1) && (u.pn >= 24);
        f32x4 bv[2][2];
#pragma unroll
        for (int bj = 0; bj < 2; ++bj)
#pragma unroll
            for (int n = 0; n < 2; ++n) bv[bj][n] = gate ? *(const f32x4*)(bias + (col0 - 6144) + bj * HALF + 4 * n) : (f32x4){0.f, 0.f, 0.f, 0.f};
#pragma unroll
        for (int ai = 0; ai < 2; ++ai)
#pragma unroll
            for (int m = 0; m < 4; ++m) { bf16_t* rowp = O + (size_t)(row0 + ai * HALF + m * 16) * ldc + col0;
#pragma unroll
                for (int bj = 0; bj < 2; ++bj) { f32x4 v0 = acc[ai][bj][m][0], v1 = acc[ai][bj][m][1];
                    if (gate) {
#pragma unroll
                        for (int j = 0; j < 4; ++j) { v0[j] = sigmoidf_(v0[j] + bv[bj][0][j]); v1[j] = sigmoidf_(v1[j] + bv[bj][1][j]); } }
                    u32x4 w; w.x = pk2(v0[0], v0[1]); w.y = pk2(v0[2], v0[3]); w.z = pk2(v1[0], v1[1]); w.w = pk2(v1[2], v1[3]);
                    *(u32x4*)(rowp + bj * HALF) = w; } }
    }
};
template <bool ACCUM> struct EpiGate {
    bf16_t* O; int ldc; const bf16_t* Gt; int ldg;
    DI void operator()(const f32x4 (&acc)[2][2][4][2], const Unit& u, int wr, int wc, int fr, int fq) const {
        const int row0 = u.pm * BM + wr * 64 + fr, col0 = u.pn * BM + wc * 32 + 8 * fq;
#pragma unroll
        for (int ai = 0; ai < 2; ++ai)
#pragma unroll
            for (int m = 0; m < 4; ++m) { const size_t row = (size_t)(row0 + ai * HALF + m * 16);
#pragma unroll
                for (int bj = 0; bj < 2; ++bj) {
                    const u32x4 gv = *(const u32x4*)(Gt + row * ldg + col0 + bj * HALF);
                    bf16_t* op = O + row * ldc + col0 + bj * HALF;
                    f32x4 v0 = acc[ai][bj][m][0], v1 = acc[ai][bj][m][1];
                    v0[0] *= bflo(gv.x); v0[1] *= bfhi(gv.x); v0[2] *= bflo(gv.y); v0[3] *= bfhi(gv.y);
                    v1[0] *= bflo(gv.z); v1[1] *= bfhi(gv.z); v1[2] *= bflo(gv.w); v1[3] *= bfhi(gv.w);
                    if (ACCUM) { const u32x4 pv = *(const u32x4*)op;
                        v0[0] += bflo(pv.x); v0[1] += bfhi(pv.x); v0[2] += bflo(pv.y); v0[3] += bfhi(pv.y);
                        v1[0] += bflo(pv.z); v1[1] += bfhi(pv.z); v1[2] += bflo(pv.w); v1[3] += bfhi(pv.w); }
                    u32x4 w; w.x = pk2(v0[0], v0[1]); w.y = pk2(v0[2], v0[3]); w.z = pk2(v1[0], v1[1]); w.w = pk2(v1[2], v1[3]);
                    *(u32x4*)op = w; } }
    }
};
struct EpiSwiGLU {
    bf16_t* O; int ldc;
    DI void operator()(const f32x4 (&acc)[2][2][4][2], const Unit& u, int wr, int wc, int fr, int fq) const {
        const int row0 = u.pm * BM + wr * 64 + fr, col0 = u.pn * HALF + wc * 32 + 8 * fq;
#pragma unroll
        for (int ai = 0; ai < 2; ++ai)
#pragma unroll
            for (int m = 0; m < 4; ++m) { bf16_t* op = O + (size_t)(row0 + ai * HALF + m * 16) * ldc + col0;
                f32x4 v0, v1;
#pragma unroll
                for (int j = 0; j < 4; ++j) { v0[j] = siluf_(acc[ai][0][m][0][j]) * acc[ai][1][m][0][j]; v1[j] = siluf_(acc[ai][0][m][1][j]) * acc[ai][1][m][1][j]; }
                u32x4 w; w.x = pk2(v0[0], v0[1]); w.y = pk2(v0[2], v0[3]); w.z = pk2(v1[0], v1[1]); w.w = pk2(v1[2], v1[3]);
                *(u32x4*)op = w; }
    }
};
}

template <class Epi>
DI void run_gemm(LAS unsigned char* lds, const bf16_t* A, const bf16_t* Bt, int M, int N, int K, const Epi& E, int cshift = 0) {
    pg8::Gemm g; g.A = A; g.Bt = Bt; g.M = M; g.N = N; g.K = K;
    pg8::StaticOrder S; S.init(M, N, (int)gridDim.x, (int)((blockIdx.x + cshift) % gridDim.x));
    pg8::gemm_phase<Epi>(lds, g, S, E);
}

DI int rowmap(int mode, int n) {
    if (mode == 0) return n;
    if (mode == 1) {
        if (n < 2048) return n;
        if (n < 3072) return 10240 + (n - 2048);
        if (n < 6144) return n - 1024;
        if (n < 7168) return 11264 + (n - 6144);
        if (n < 8192) return 5120 + (n - 7168);
        return 6144 + (n - 8192);
    }
    const int up = n >= DFF, j = up ? n - DFF : n;
    return 256 * (j >> 7) + (up ? 128 : 0) + (j & 127);
}
DI void transpose_tile(const float* __restrict__ W, int K, int N, bf16_t* __restrict__ WT, int mode, int tile, LAS unsigned char* lds) {
    const int tid = otid();
    const int nb = N >> 6, kb = tile / nb, nbk = tile - kb * nb, k0 = kb << 6, n0 = nbk << 6;
    LAS bf16_t* T = (LAS bf16_t*)lds;
    const int r = tid >> 4, c4 = (tid & 15) * 4;
#pragma unroll
    for (int i = 0; i < 2; ++i) { const int kk = r + 32 * i;
        const f32x4 v = *(const f32x4*)(W + (size_t)(k0 + kk) * N + n0 + c4);
        const unsigned p0 = pk2(v[0], v[1]), p1 = pk2(v[2], v[3]);
        T[(c4 + 0) * 72 + kk] = (bf16_t)(p0 & 0xffffu); T[(c4 + 1) * 72 + kk] = (bf16_t)(p0 >> 16);
        T[(c4 + 2) * 72 + kk] = (bf16_t)(p1 & 0xffffu); T[(c4 + 3) * 72 + kk] = (bf16_t)(p1 >> 16); }
    __syncthreads();
    { const int n = tid >> 3, part = tid & 7;
      const u32x4 o = *(const LAS u32x4*)(lds + n * 144 + part * 16);
      const int row = rowmap(mode, n0 + n);
      *(u32x4*)(WT + (size_t)row * K + k0 + part * 8) = o; }
    __syncthreads();
}

template <bool XIN_BF, bool XOUT_BF>
DI void rowpass(const void* xin_, const bf16_t* __restrict__ y, const float* __restrict__ gpost, void* xout_,
                const float* __restrict__ gpre, bf16_t* __restrict__ hout, int nrows, int b0 = 0, int nb = 0) {
    if (nb == 0) nb = (int)gridDim.x;
    if ((int)blockIdx.x < b0 || (int)blockIdx.x >= b0 + nb) return;
    const int tid_ = otid(); const int lane = tid_ & 63, gw = ((int)blockIdx.x - b0) * 8 + (tid_ >> 6), ngw = nb * 8;
    for (int r = gw; r < nrows; r += ngw) {
        f32x4 xv[8];
        if (XIN_BF) { const bf16_t* xr = (const bf16_t*)xin_ + (size_t)r * DM + lane * 4;
#pragma unroll
            for (int j = 0; j < 8; ++j) { const u32x2 u = *(const u32x2*)(xr + j * 256); xv[j] = (f32x4){bflo(u.x), bfhi(u.x), bflo(u.y), bfhi(u.y)}; }
        } else { const float* xr = (const float*)xin_ + (size_t)r * DM + lane * 4;
#pragma unroll
            for (int j = 0; j < 8; ++j) xv[j] = __builtin_nontemporal_load((const f32x4*)(xr + j * 256)); }
        if (y) {
            const bf16_t* yr = y + (size_t)r * DM + lane * 4;
            f32x4 yv[8]; float ss = 0.f;
#pragma unroll
            for (int j = 0; j < 8; ++j) { const u32x2 u = *(const u32x2*)(yr + j * 256); yv[j] = (f32x4){bflo(u.x), bfhi(u.x), bflo(u.y), bfhi(u.y)};
                ss += yv[j][0] * yv[j][0] + yv[j][1] * yv[j][1] + yv[j][2] * yv[j][2] + yv[j][3] * yv[j][3]; }
            ss = wave_sum(ss);
            const float r1 = rsqrtf(ss * (1.f / DM) + EPS);
#pragma unroll
            for (int j = 0; j < 8; ++j) { const f32x4 gg = *(const f32x4*)(gpost + j * 256 + lane * 4); xv[j] += yv[j] * r1 * gg; }
        }
        if (xout_) {
            if (XOUT_BF) { bf16_t* xo = (bf16_t*)xout_ + (size_t)r * DM + lane * 4;
#pragma unroll
                for (int j = 0; j < 8; ++j) { u32x2 w; w.x = pk2(xv[j][0], xv[j][1]); w.y = pk2(xv[j][2], xv[j][3]); *(u32x2*)(xo + j * 256) = w;
                    xv[j] = (f32x4){bflo(w.x), bfhi(w.x), bflo(w.y), bfhi(w.y)}; }
            } else { float* xo = (float*)xout_ + (size_t)r * DM + lane * 4;
#pragma unroll
                for (int j = 0; j < 8; ++j) __builtin_nontemporal_store(xv[j], (f32x4*)(xo + j * 256)); }
        }
        if (hout) {
            float ss = 0.f;
#pragma unroll
            for (int j = 0; j < 8; ++j) ss += xv[j][0] * xv[j][0] + xv[j][1] * xv[j][1] + xv[j][2] * xv[j][2] + xv[j][3] * xv[j][3];
            ss = wave_sum(ss);
            const float r2 = rsqrtf(ss * (1.f / DM) + EPS);
            bf16_t* ho = hout + (size_t)r * DM + lane * 4;
#pragma unroll
            for (int j = 0; j < 8; ++j) { const f32x4 gg = *(const f32x4*)(gpre + j * 256 + lane * 4); const f32x4 hv = xv[j] * r2 * gg;
                u32x2 w; w.x = pk2(hv[0], hv[1]); w.y = pk2(hv[2], hv[3]); *(u32x2*)(ho + j * 256) = w; }
        }
    }
}

DI void hgrn_combine(const bf16_t* __restrict__ OF, const bf16_t* __restrict__ OB, const bf16_t* __restrict__ PROJ, const float* __restrict__ gn, bf16_t* __restrict__ YB, int nrows) {
    const int tid_ = otid(); const int lane = tid_ & 63, gw = blockIdx.x * 8 + (tid_ >> 6), ngw = gridDim.x * 8;
    for (int r = gw; r < nrows; r += ngw) {
        float o[16]; float ss = 0.f;
#pragma unroll
        for (int hlf = 0; hlf < 2; ++hlf) {
            const u32x4 a = *(const u32x4*)(OF + (size_t)r * 1024 + lane * 16 + hlf * 8);
            const u32x4 b = *(const u32x4*)(OB + (size_t)r * 1024 + lane * 16 + hlf * 8);
#pragma unroll
            for (int k = 0; k < 4; ++k) { o[hlf * 8 + 2 * k] = bflo(a[k]) + bflo(b[k]); o[hlf * 8 + 2 * k + 1] = bfhi(a[k]) + bfhi(b[k]); }
        }
#pragma unroll
        for (int k = 0; k < 16; ++k) ss += o[k] * o[k];
        ss += __shfl_xor(ss, 1); ss += __shfl_xor(ss, 2); ss += __shfl_xor(ss, 4);
        const float rr = rsqrtf(ss * (1.f / 128.f) + EPS);
#pragma unroll
        for (int hlf = 0; hlf < 2; ++hlf) {
            const u32x4 gbv = *(const u32x4*)(PROJ + (size_t)r * NPROJ + 5120 + lane * 16 + hlf * 8);
            const f32x4 g0 = *(const f32x4*)(gn + (lane & 7) * 16 + hlf * 8), g1 = *(const f32x4*)(gn + (lane & 7) * 16 + hlf * 8 + 4);
            float v[8];
#pragma unroll
            for (int k = 0; k < 4; ++k) { v[2 * k] = siluf_(bflo(gbv[k])); v[2 * k + 1] = siluf_(bfhi(gbv[k])); }
            u32x4 w;
            w.x = pk2(o[hlf * 8 + 0] * rr * g0[0] * v[0], o[hlf * 8 + 1] * rr * g0[1] * v[1]);
            w.y = pk2(o[hlf * 8 + 2] * rr * g0[2] * v[2], o[hlf * 8 + 3] * rr * g0[3] * v[3]);
            w.z = pk2(o[hlf * 8 + 4] * rr * g1[0] * v[4], o[hlf * 8 + 5] * rr * g1[1] * v[5]);
            w.w = pk2(o[hlf * 8 + 6] * rr * g1[2] * v[6], o[hlf * 8 + 7] * rr * g1[3] * v[7]);
            *(u32x4*)(YB + (size_t)r * 1024 + lane * 16 + hlf * 8) = w;
        }
    }
}

DI void hgrn_combine_head(const bf16_t* __restrict__ OF, const bf16_t* __restrict__ OB, const bf16_t* __restrict__ PROJ, const float* __restrict__ gn, bf16_t* __restrict__ YB, int row0, int S, int head) {
    const int tid = otid(), lane = tid & 63, wv = tid >> 6, sub = lane & 7;
    const f32x4 g0 = *(const f32x4*)(gn + sub * 16), g1 = *(const f32x4*)(gn + sub * 16 + 4), g2 = *(const f32x4*)(gn + sub * 16 + 8), g3 = *(const f32x4*)(gn + sub * 16 + 12);
    for (int r = row0 + wv * 8 + (lane >> 3); r < row0 + S; r += 64) {
        const size_t off = (size_t)r * 1024 + head * 128 + sub * 16;
        float o[16]; float ss = 0.f;
#pragma unroll
        for (int hlf = 0; hlf < 2; ++hlf) {
            const u32x4 a = *(const u32x4*)(OF + off + hlf * 8);
            const u32x4 b = *(const u32x4*)(OB + off + hlf * 8);
#pragma unroll
            for (int k = 0; k < 4; ++k) { o[hlf * 8 + 2 * k] = bflo(a[k]) + bflo(b[k]); o[hlf * 8 + 2 * k + 1] = bfhi(a[k]) + bfhi(b[k]); }
        }
#pragma unroll
        for (int k = 0; k < 16; ++k) ss += o[k] * o[k];
        ss += __shfl_xor(ss, 1); ss += __shfl_xor(ss, 2); ss += __shfl_xor(ss, 4);
        const float rr = rsqrtf(ss * (1.f / 128.f) + EPS);
#pragma unroll
        for (int hlf = 0; hlf < 2; ++hlf) {
            const u32x4 gbv = *(const u32x4*)(PROJ + (size_t)r * NPROJ + 5120 + head * 128 + sub * 16 + hlf * 8);
            const f32x4 ga = hlf ? g2 : g0, gb = hlf ? g3 : g1;
            float v[8];
#pragma unroll
            for (int k = 0; k < 4; ++k) { v[2 * k] = siluf_(bflo(gbv[k])); v[2 * k + 1] = siluf_(bfhi(gbv[k])); }
            u32x4 w;
            w.x = pk2(o[hlf * 8 + 0] * rr * ga[0] * v[0], o[hlf * 8 + 1] * rr * ga[1] * v[1]);
            w.y = pk2(o[hlf * 8 + 2] * rr * ga[2] * v[2], o[hlf * 8 + 3] * rr * ga[3] * v[3]);
            w.z = pk2(o[hlf * 8 + 4] * rr * gb[0] * v[4], o[hlf * 8 + 5] * rr * gb[1] * v[5]);
            w.w = pk2(o[hlf * 8 + 6] * rr * gb[2] * v[6], o[hlf * 8 + 7] * rr * gb[3] * v[7]);
            *(u32x4*)(YB + off + hlf * 8) = w;
        }
    }
}

constexpr int AT_KB = 64 * 272, AT_VB = 128 * 144;
constexpr int AT_K0 = 0, AT_V0 = 4 * AT_KB, AT_TAB = 4 * AT_KB + 4 * AT_VB, AT_EX = 0;
DI bf16x8 ld_vfrag(const LAS unsigned char* vp) { return *(const LAS bf16x8*)vp; }
DI void attn_pv(const LAS unsigned char* vb, const bf16x8 (&pf)[2][2], f32x16 (&o)[4]) {
    bf16x8 va[4], vc[4];
#pragma unroll
    for (int et = 0; et < 4; ++et) va[et] = ld_vfrag(vb + et * 32 * 144);
    __builtin_amdgcn_sched_barrier(0);
#pragma unroll
    for (int et = 0; et < 4; ++et) vc[et] = ld_vfrag(vb + et * 32 * 144 + 32);
#pragma unroll
    for (int et = 0; et < 4; ++et) o[et] = MFMA32(va[et], pf[0][0], o[et]);
    __builtin_amdgcn_sched_barrier(0);
#pragma unroll
    for (int et = 0; et < 4; ++et) va[et] = ld_vfrag(vb + et * 32 * 144 + 64);
#pragma unroll
    for (int et = 0; et < 4; ++et) o[et] = MFMA32(vc[et], pf[0][1], o[et]);
    __builtin_amdgcn_sched_barrier(0);
#pragma unroll
    for (int et = 0; et < 4; ++et) vc[et] = ld_vfrag(vb + et * 32 * 144 + 96);
#pragma unroll
    for (int et = 0; et < 4; ++et) o[et] = MFMA32(va[et], pf[1][0], o[et]);
    __builtin_amdgcn_sched_barrier(0);
#pragma unroll
    for (int et = 0; et < 4; ++et) o[et] = MFMA32(vc[et], pf[1][1], o[et]);
}
template <int KSTEPS, bool DIFF>
DI void attn_unit(LAS unsigned char* lds, const bf16_t* __restrict__ Q, int ldq, const bf16_t* __restrict__ Kg, int ldk,
                  const bf16_t* __restrict__ VT, size_t ldvt, int nkeys, int qpos0, const float* __restrict__ relb, CParams lamp,
                  const float* __restrict__ gsub, bf16_t* __restrict__ O, int ldo, float c1) {
    const int tid = otid(), wid = tid >> 6, lane = tid & 63, ql = lane & 31, h = lane >> 5;
    const int grp = wid >> 2;
    const int c = DIFF ? grp : 0;
    const int qrow0 = DIFF ? (wid & 3) * 32 : wid * 32;
    LAS float* tab = (LAS float*)(lds + AT_TAB);
    if (DIFF) {
        if (tid < 257) { const int rel = tid - 128; const int n = rel < 0 ? -rel : rel;
            int b;
            if (n < 8) b = n; else { b = 8 + (int)(__logf((float)n * 0.125f) * (8.f / 2.772588722239781f) + 1e-4f); b = b > 15 ? 15 : b; }
            if (rel > 0) b += 16;
            tab[tid] = relb[b * 8] * LOG2E; }
    }
    bf16x8 qf[KSTEPS];
    { const bf16_t* qp = Q + (size_t)(qrow0 + ql) * ldq + c * 64 + h * 8;
#pragma unroll
      for (int ks = 0; ks < KSTEPS; ++ks) { const u32x4 r = *(const u32x4*)(qp + ks * 16);
          u32x4 w; w.x = pk2(bflo(r.x) * c1, bfhi(r.x) * c1); w.y = pk2(bflo(r.y) * c1, bfhi(r.y) * c1); w.z = pk2(bflo(r.z) * c1, bfhi(r.z) * c1); w.w = pk2(bflo(r.w) * c1, bfhi(r.w) * c1);
          qf[ks] = __builtin_bit_cast(bf16x8, w); } }
    const int kkey0 = tid >> 4, kpart = tid & 15;
    const int ve0 = tid >> 3, vpart = tid & 7;
    u32x4 kreg[2][2], vreg[2][2];
    const bf16_t* kgp = Kg + (size_t)kkey0 * ldk + kpart * 8;
    const bf16_t* vgp = VT + (size_t)ve0 * ldvt + vpart * 8;
    LAS unsigned char* kst = lds + AT_K0 + kkey0 * 272 + kpart * 16;
    LAS unsigned char* vst = lds + AT_V0 + ve0 * 144 + (vpart >> 1) * 32 + (vpart & 1) * 8;
#define AT_LOAD(st, kt) do { kreg[st][0] = *(const u32x4*)(kgp + (size_t)((kt) * 64) * ldk); kreg[st][1] = *(const u32x4*)(kgp + (size_t)((kt) * 64 + 32) * ldk); \
        vreg[st][0] = *(const u32x4*)(vgp + (kt) * 64); vreg[st][1] = *(const u32x4*)(vgp + (size_t)64 * ldvt + (kt) * 64); } while (0)
#define AT_STORE(st, kb, vb) do { LAS unsigned char* _k = kst + (kb) * AT_KB; LAS unsigned char* _v = vst + (vb) * AT_VB; \
        *(LAS u32x4*)_k = kreg[st][0]; *(LAS u32x4*)(_k + 32 * 272) = kreg[st][1]; \
        *(LAS u32x2*)_v = (u32x2){vreg[st][0].x, vreg[st][0].y}; *(LAS u32x2*)(_v + 16) = (u32x2){vreg[st][0].z, vreg[st][0].w}; \
        *(LAS u32x2*)(_v + 64 * 144) = (u32x2){vreg[st][1].x, vreg[st][1].y}; *(LAS u32x2*)(_v + 64 * 144 + 16) = (u32x2){vreg[st][1].z, vreg[st][1].w}; } while (0)
#define AT_PV(vb) attn_pv(lds + AT_V0 + (vb) * AT_VB + ql * 144 + 16 * h, pf, o)
    AT_LOAD(0, 0); AT_STORE(0, 0, 0);
    AT_LOAD(0, 1); AT_STORE(0, 1, 1);
    __syncthreads();
    const int nT = nkeys >> 7;
    f32x16 o[4];
#pragma unroll
    for (int et = 0; et < 4; ++et)
#pragma unroll
        for (int i = 0; i < 16; ++i) o[et][i] = 0.f;
    float m = -1e30f, mpend = -1e30f; bool need = false;
    float l0 = 0.f, l1 = 0.f;
    const int qpos = qpos0 + qrow0 + ql;
#define AT_QK(SLOTH, KT) do { \
        bc = 0.f; perel = false; \
        if (DIFF) { const int relmin = (KT) * 64 - (qpos0 + qrow0 + 31), relmax = (KT) * 64 + 63 - (qpos0 + qrow0); \
            if (relmin >= 128) bc = tab[256]; else if (relmax <= -128) bc = tab[0]; else perel = true; } \
        f32x16 ninit; { const float want = ((KT) == 0) ? 0.f : bc - m; _Pragma("unroll") for (int i = 0; i < 16; ++i) ninit[i] = want; } \
        const LAS unsigned char* kb = lds + AT_K0 + (SLOTH) * AT_KB + ql * 272 + (c * 64 + h * 8) * 2; \
        _Pragma("unroll") for (int ksb = 0; ksb < KSTEPS / 4; ++ksb) { \
            bf16x8 kf[2][4]; \
            _Pragma("unroll") for (int kt2 = 0; kt2 < 2; ++kt2) _Pragma("unroll") for (int j = 0; j < 4; ++j) kf[kt2][j] = *(const LAS bf16x8*)(kb + kt2 * 32 * 272 + (ksb * 4 + j) * 32); \
            __builtin_amdgcn_sched_barrier(0); \
            _Pragma("unroll") for (int j = 0; j < 4; ++j) _Pragma("unroll") for (int kt2 = 0; kt2 < 2; ++kt2) s[kt2] = MFMA32(kf[kt2][j], qf[ksb * 4 + j], (ksb == 0 && j == 0) ? ninit : s[kt2]); \
            __builtin_amdgcn_sched_barrier(0); } \
        if (DIFF && perel) { \
            _Pragma("unroll") for (int kt2 = 0; kt2 < 2; ++kt2) _Pragma("unroll") for (int i = 0; i < 16; ++i) { \
                const int kpos = (KT) * 64 + kt2 * 32 + (i & 3) + 8 * (i >> 2) + 4 * h; \
                int idx = kpos - qpos + 128; idx = idx < 0 ? 0 : (idx > 256 ? 256 : idx); \
                s[kt2][i] += tab[idx]; } } \
    } while (0)
    for (int T0 = 0; T0 < nT; T0 += 2) {
#pragma unroll
      for (int slot = 0; slot < 2; ++slot) {
        const int T = T0 + slot;
        const bool more = T + 1 < nT;
        if (DIFF && more) AT_LOAD(0, 2 * T + 2);
        f32x16 s[2]; float bc; bool perel;
        bf16x8 pfa[2][2], pfb[2][2];
        if (need) { const float alpha = fexp2(m - mpend); m = mpend; l0 *= alpha; l1 *= alpha;
#pragma unroll
            for (int et = 0; et < 4; ++et)
#pragma unroll
                for (int i = 0; i < 16; ++i) o[et][i] *= alpha; }
        AT_QK(slot * 2 + 0, 2 * T);
        if (T == 0) {
            float mx = s[0][0];
#pragma unroll
            for (int kt2 = 0; kt2 < 2; ++kt2)
#pragma unroll
                for (int i = 0; i < 16; ++i) mx = fmaxf(mx, s[kt2][i]);
            { const auto r = __builtin_amdgcn_permlane32_swap(__float_as_uint(mx), __float_as_uint(mx), false, false); mx = fmaxf(__uint_as_float(r[0]), __uint_as_float(r[1])); }
            m = mx + bc;
#pragma unroll
            for (int kt2 = 0; kt2 < 2; ++kt2)
#pragma unroll
                for (int i = 0; i < 16; ++i) s[kt2][i] -= mx;
        }
        {
            float mx = s[0][0];
#pragma unroll
            for (int kt2 = 0; kt2 < 2; ++kt2) {
                float p[16];
#pragma unroll
                for (int i = 0; i < 16; ++i) { p[i] = fexp2(s[kt2][i]); mx = fmaxf(mx, s[kt2][i]); }
#pragma unroll
                for (int i = 0; i < 16; i += 2) { l0 += p[i]; l1 += p[i + 1]; }
#pragma unroll
                for (int sp = 0; sp < 2; ++sp) {
                    u32x4 w; w.x = pk2(p[8 * sp + 0], p[8 * sp + 1]); w.y = pk2(p[8 * sp + 2], p[8 * sp + 3]); w.z = pk2(p[8 * sp + 4], p[8 * sp + 5]); w.w = pk2(p[8 * sp + 6], p[8 * sp + 7]);
                    pfa[kt2][sp] = __builtin_bit_cast(bf16x8, w);
                }
            }
            { const auto r = __builtin_amdgcn_permlane32_swap(__float_as_uint(mx), __float_as_uint(mx), false, false); mx = fmaxf(__uint_as_float(r[0]), __uint_as_float(r[1])); }
            need = __any(mx > 8.f) != 0;
            mpend = m + fmaxf(mx, 0.f);
        }
        if (more) { if (!DIFF) AT_LOAD(0, 2 * T + 2); AT_STORE(0, (slot ^ 1) * 2 + 0, (slot ^ 1) * 2 + 0); if (DIFF) AT_LOAD(0, 2 * T + 3); }
        float alpha = 1.f; bool resc = false;
        if (need) { alpha = fexp2(m - mpend); m = mpend; resc = true; l0 *= alpha; l1 *= alpha; }
        AT_QK(slot * 2 + 1, 2 * T + 1);
        __builtin_amdgcn_sched_barrier(0);
        {
            float mx = s[0][0];
            unsigned pw[16];
            const LAS unsigned char* vb = lds + AT_V0 + (slot * 2 + 0) * AT_VB + ql * 144 + 16 * h;
            bf16x8 vf[3];
            vf[0] = *(const LAS bf16x8*)(vb);
            vf[1] = *(const LAS bf16x8*)(vb + 1 * 32 * 144);
            __builtin_amdgcn_sched_barrier(0);
#pragma unroll
            for (int i = 0; i < 16; ++i) {
                if (i + 2 < 16) vf[(i + 2) % 3] = *(const LAS bf16x8*)(vb + ((i + 2) & 3) * 32 * 144 + ((i + 2) >> 2) * 32);
                o[i & 3] = MFMA32(vf[i % 3], pfa[i >> 3][(i >> 2) & 1], o[i & 3]);
                const float a0 = s[(2 * i) >> 4][(2 * i) & 15], a1 = s[(2 * i + 1) >> 4][(2 * i + 1) & 15];
                const float p0 = fexp2(a0), p1 = fexp2(a1);
                l0 += p0; l1 += p1;
                mx = fmaxf(mx, a0); mx = fmaxf(mx, a1);
                pw[i] = pk2(p0, p1);
                __builtin_amdgcn_sched_barrier(0);
            }
#pragma unroll
            for (int kt2 = 0; kt2 < 2; ++kt2)
#pragma unroll
                for (int sp = 0; sp < 2; ++sp) { const u32x4 w = {pw[kt2 * 8 + sp * 4], pw[kt2 * 8 + sp * 4 + 1], pw[kt2 * 8 + sp * 4 + 2], pw[kt2 * 8 + sp * 4 + 3]}; pfb[kt2][sp] = __builtin_bit_cast(bf16x8, w); }
            { const auto r = __builtin_amdgcn_permlane32_swap(__float_as_uint(mx), __float_as_uint(mx), false, false); mx = fmaxf(__uint_as_float(r[0]), __uint_as_float(r[1])); }
            need = __any(mx > 8.f) != 0;
            mpend = m + fmaxf(mx, 0.f);
        }
        __builtin_amdgcn_sched_barrier(0);
        if (resc) {
#pragma unroll
            for (int et = 0; et < 4; ++et)
#pragma unroll
                for (int i = 0; i < 16; ++i) o[et][i] *= alpha;
        }
        attn_pv(lds + AT_V0 + (slot * 2 + 1) * AT_VB + ql * 144 + 16 * h, pfb, o);
        if (more) { if (!DIFF) AT_LOAD(0, 2 * T + 3); AT_STORE(0, (slot ^ 1) * 2 + 1, (slot ^ 1) * 2 + 1); }
        __syncthreads();
      }
    }
#undef AT_QK
#undef AT_LOAD
#undef AT_STORE
#undef AT_PV
    float l2[2] = {l0, l1};
    float l = l2[0] + l2[1];
    l += __shfl_xor(l, 32);
    const float inv = 1.f / l;
    if (DIFF) {
        const float lam = fexp(wave_sum(lamp->in[9][lane] * lamp->in[10][lane])) - fexp(wave_sum(lamp->in[11][lane] * lamp->in[12][lane])) + 0.2f;
        const float sc = (c == 0) ? inv : -lam * inv;
        LAS float* ex = (LAS float*)(lds + AT_EX) + (qrow0 + ql) * 132;
        __syncthreads();
        if (c == 1) {
#pragma unroll
            for (int et = 0; et < 4; ++et)
#pragma unroll
                for (int ig = 0; ig < 4; ++ig)
                    *(LAS f32x4*)(ex + 32 * et + 8 * ig + 4 * h) = (f32x4){o[et][4 * ig] * sc, o[et][4 * ig + 1] * sc, o[et][4 * ig + 2] * sc, o[et][4 * ig + 3] * sc};
        }
        __syncthreads();
        if (c == 0) {
            float ss = 0.f;
#pragma unroll
            for (int et = 0; et < 4; ++et)
#pragma unroll
                for (int ig = 0; ig < 4; ++ig) {
                    const f32x4 b = *(const LAS f32x4*)(ex + 32 * et + 8 * ig + 4 * h);
#pragma unroll
                    for (int j = 0; j < 4; ++j) { const float v = o[et][4 * ig + j] * sc + b[j]; o[et][4 * ig + j] = v; ss += v * v; }
                }
            ss += __shfl_xor(ss, 32);
            const float rr = rsqrtf(ss * (1.f / 128.f) + EPS) * 0.8f;
            bf16_t* op = O + (size_t)(qrow0 + ql) * ldo;
#pragma unroll
            for (int et = 0; et < 4; ++et)
#pragma unroll
                for (int ig = 0; ig < 4; ++ig) {
                    const int e0 = 32 * et + 8 * ig + 4 * h;
                    const f32x4 gg = *(const f32x4*)(gsub + e0);
                    u32x2 w; w.x = pk2(o[et][4 * ig] * rr * gg[0], o[et][4 * ig + 1] * rr * gg[1]); w.y = pk2(o[et][4 * ig + 2] * rr * gg[2], o[et][4 * ig + 3] * rr * gg[3]);
                    *(u32x2*)(op + e0) = w;
                }
        }
        __syncthreads();
    } else {
        bf16_t* op = O + (size_t)(qrow0 + ql) * ldo;
#pragma unroll
        for (int et = 0; et < 4; ++et)
#pragma unroll
            for (int ig = 0; ig < 4; ++ig) {
                const int e0 = 32 * et + 8 * ig + 4 * h;
                u32x2 w; w.x = pk2(o[et][4 * ig] * inv, o[et][4 * ig + 1] * inv); w.y = pk2(o[et][4 * ig + 2] * inv, o[et][4 * ig + 3] * inv);
                *(u32x2*)(op + e0) = w;
            }
        __syncthreads();
    }
}

constexpr int HG_QS = 0, HG_KS = 17408, HG_KST = 34816, HG_VTS = 53248, HG_AS = 71680, HG_SEG = 80896, HG_ER = 84992, HG_EL = 85504;
template <int DIR>
DI void hgrn_item(LAS unsigned char* lds, const bf16_t* __restrict__ PROJ, const bf16_t* __restrict__ VT, int row0, int S, int head,
                  const float* __restrict__ lblog, bf16_t* __restrict__ Oout) {
    const int tid = otid(), w = tid >> 6, lane = tid & 63, r16 = lane & 15, quad = lane >> 4;
    const int dp = lane, seg = w, d0 = 2 * dp;
    float lb0, lb1;
    { const float* lp = lblog + DIR * 2048 + head * 128 + d0;
      lb0 = frcp(1.f + fexp(lp[1024] - lp[0])); lb1 = frcp(1.f + fexp(lp[1025] - lp[1])); }
    const float SC = 0.08838834764831845f;
    const int nch = S >> 6;
    f32x4 st[8];
#pragma unroll
    for (int i = 0; i < 8; ++i) st[i] = (f32x4){0.f, 0.f, 0.f, 0.f};
    unsigned zq[2][8], qq[2][8]; u32x4 vt[2];
    const bf16_t* zbase = PROJ + 3072 + DIR * 1024 + head * 128 + d0;
    const bf16_t* qbase = PROJ + 2048 + head * 128 + d0;
    const bf16_t* vbase = VT + (size_t)(1024 + head * 128 + (tid >> 3)) * GR + (tid & 7) * 8;
#define HG_LOAD(st, trow) do { _Pragma("unroll") for (int i = 0; i < 8; ++i) { const size_t ro = (size_t)((trow) + seg * 8 + i) * NPROJ; zq[st][i] = *(const unsigned*)(zbase + ro); qq[st][i] = *(const unsigned*)(qbase + ro); } \
        } while (0)
#define HG_LOADV(trow) do { vt[0] = *(const u32x4*)(vbase + (trow)); vt[1] = *(const u32x4*)(vbase + (size_t)64 * GR + (trow)); } while (0)
    { const int n0 = DIR ? nch - 1 : 0, n1 = DIR ? nch - 2 : 1; HG_LOAD(0, row0 + n0 * 64); HG_LOADV(row0 + n0 * 64); HG_LOAD(1, row0 + n1 * 64); }
    for (int ci0 = 0; ci0 < nch; ci0 += 2) {
#pragma unroll
      for (int par = 0; par < 2; ++par) {
        const int ci = ci0 + par;
        const int n = DIR ? nch - 1 - ci : ci;
        const int trow = row0 + n * 64;
        float bl0[8], bl1[8], k0[8], k1[8], q0[8], q1[8];
        float run0 = 0.f, run1 = 0.f;
#pragma unroll
        for (int ii = 0; ii < 8; ++ii) { const int i = DIR ? 7 - ii : ii;
            const float z0 = bflo(zq[par][i]), z1 = bfhi(zq[par][i]);
            const float s0 = sigmoidf_(z0), s1 = sigmoidf_(z1);
            const float f0 = lb0 + (1.f - lb0) * s0, f1 = lb1 + (1.f - lb1) * s1;
            run0 += __logf(f0); run1 += __logf(f1);
            bl0[i] = run0; bl1[i] = run1;
            k0[i] = (1.f - lb0) * (1.f - s0); k1[i] = (1.f - lb1) * (1.f - s1);
            q0[i] = bflo(qq[par][i]) * SC; q1[i] = bfhi(qq[par][i]) * SC; }
        *(LAS f32x2*)(lds + HG_SEG + (seg * 128 + d0) * 4) = (f32x2){run0, run1};
        *(LAS u32x4*)(lds + HG_VTS + (tid >> 3) * 144 + (tid & 7) * 16) = vt[0];
        *(LAS u32x4*)(lds + HG_VTS + ((tid >> 3) + 64) * 144 + (tid & 7) * 16) = vt[1];
        if (ci + 2 < nch) { const int n2 = DIR ? n - 2 : n + 2; HG_LOAD(par, row0 + n2 * 64); }
        if (ci + 1 < nch) { const int n1 = DIR ? n - 1 : n + 1; HG_LOADV(row0 + n1 * 64); }
        __syncthreads();
        {
            float off0 = 0.f, off1 = 0.f, ref0 = 0.f, ref1 = 0.f, tot0 = 0.f, tot1 = 0.f;
#pragma unroll
            for (int s2 = 0; s2 < 8; ++s2) { const f32x2 t = *(const LAS f32x2*)(lds + HG_SEG + (s2 * 128 + d0) * 4);
                tot0 += t[0]; tot1 += t[1];
                const bool before = DIR ? (s2 > seg) : (s2 < seg);
                const bool inref = DIR ? (s2 >= 4) : (s2 < 4);
                if (before) { off0 += t[0]; off1 += t[1]; }
                if (inref) { ref0 += t[0]; ref1 += t[1]; } }
            unsigned kt0[4], kt1[4];
            float ksv0[8], ksv1[8];
#pragma unroll
            for (int i = 0; i < 8; ++i) {
                const float b0 = off0 + bl0[i] - ref0, b1 = off1 + bl1[i] - ref1;
                const float qs0 = q0[i] * fexp(b0), qs1 = q1[i] * fexp(b1);
                ksv0[i] = k0[i] * fexp(-b0); ksv1[i] = k1[i] * fexp(-b1);
                *(LAS unsigned*)(lds + HG_QS + (seg * 8 + i) * 272 + d0 * 2) = pk2(qs0, qs1);
                *(LAS unsigned*)(lds + HG_KS + (seg * 8 + i) * 272 + d0 * 2) = pk2(ksv0[i], ksv1[i]);
            }
#pragma unroll
            for (int i = 0; i < 4; ++i) { kt0[i] = pk2(ksv0[2 * i], ksv0[2 * i + 1]); kt1[i] = pk2(ksv1[2 * i], ksv1[2 * i + 1]); }
            *(LAS u32x4*)(lds + HG_KST + d0 * 144 + seg * 16) = (u32x4){kt0[0], kt0[1], kt0[2], kt0[3]};
            *(LAS u32x4*)(lds + HG_KST + (d0 + 1) * 144 + seg * 16) = (u32x4){kt1[0], kt1[1], kt1[2], kt1[3]};
            if (seg == 0) {
                *(LAS f32x2*)(lds + HG_ER + d0 * 4) = (f32x2){fexp(ref0), fexp(ref1)};
                *(LAS f32x2*)(lds + HG_EL + d0 * 4) = (f32x2){fexp(tot0 - ref0), fexp(tot1 - ref1)};
            }
        }
        __syncthreads();
        bf16x8 vfr[2];
#pragma unroll
        for (int ks2 = 0; ks2 < 2; ++ks2) vfr[ks2] = *(const LAS bf16x8*)(lds + HG_VTS + (16 * w + r16) * 144 + (ks2 * 32 + quad * 8) * 2);
        {
            const int stl = w & 3;
            bf16x8 af[4], bq[2][4];
#pragma unroll
            for (int ks = 0; ks < 4; ++ks) af[ks] = *(const LAS bf16x8*)(lds + HG_KS + (16 * stl + r16) * 272 + (32 * ks + 8 * quad) * 2);
#pragma unroll
            for (int tti = 0; tti < 2; ++tti)
#pragma unroll
                for (int ks = 0; ks < 4; ++ks) bq[tti][ks] = *(const LAS bf16x8*)(lds + HG_QS + (16 * (2 * (w >> 2) + tti) + r16) * 272 + (32 * ks + 8 * quad) * 2);
            __builtin_amdgcn_sched_barrier(0);
            f32x4 acc[2] = {(f32x4){0.f, 0.f, 0.f, 0.f}, (f32x4){0.f, 0.f, 0.f, 0.f}};
#pragma unroll
            for (int ks = 0; ks < 4; ++ks)
#pragma unroll
                for (int tti = 0; tti < 2; ++tti) acc[tti] = MFMA16(af[ks], bq[tti][ks], acc[tti]);
#pragma unroll
            for (int tti = 0; tti < 2; ++tti) {
                const int t = 16 * (2 * (w >> 2) + tti) + r16, sb = 16 * stl + 4 * quad;
#pragma unroll
                for (int j = 0; j < 4; ++j) { const bool keep = DIR ? (sb + j >= t) : (t >= sb + j); acc[tti][j] = keep ? acc[tti][j] : 0.f; }
                *(LAS u32x2*)(lds + HG_AS + t * 144 + sb * 2) = (u32x2){pk2(acc[tti][0], acc[tti][1]), pk2(acc[tti][2], acc[tti][3])};
            }
        }
        f32x4 oacc[4];
#pragma unroll
        for (int tt = 0; tt < 4; ++tt) oacc[tt] = (f32x4){0.f, 0.f, 0.f, 0.f};
        {
            bf16x8 qfr[2][4];
            f32x4 ea[2], eb[2];
#define HG_LDQ(buf, ks) do { ea[buf] = *(const LAS f32x4*)(lds + HG_ER + (32 * (ks) + 4 * quad) * 4); eb[buf] = *(const LAS f32x4*)(lds + HG_ER + (32 * (ks) + 16 + 4 * quad) * 4); \
            _Pragma("unroll") for (int tt = 0; tt < 4; ++tt) { const LAS unsigned char* qp = lds + HG_QS + (16 * tt + r16) * 272 + (32 * (ks) + 4 * quad) * 2; \
                const s16x4 lo = *(const LAS s16x4*)qp, hi = *(const LAS s16x4*)(qp + 32); qfr[buf][tt] = __builtin_shufflevector(lo, hi, 0, 1, 2, 3, 4, 5, 6, 7); } } while (0)
            HG_LDQ(0, 0);
#pragma unroll
            for (int ks = 0; ks < 4; ++ks) {
                const int cb = ks & 1;
                if (ks + 1 < 4) HG_LDQ(cb ^ 1, ks + 1);
                __builtin_amdgcn_sched_barrier(0);
                st[2 * ks] *= ea[cb]; st[2 * ks + 1] *= eb[cb];
                const u32x4 bw = (u32x4){pk2(st[2 * ks][0], st[2 * ks][1]), pk2(st[2 * ks][2], st[2 * ks][3]), pk2(st[2 * ks + 1][0], st[2 * ks + 1][1]), pk2(st[2 * ks + 1][2], st[2 * ks + 1][3])};
                const bf16x8 bfrag = __builtin_bit_cast(bf16x8, bw);
#pragma unroll
                for (int tt = 0; tt < 4; ++tt) oacc[tt] = MFMA16(qfr[cb][tt], bfrag, oacc[tt]);
            }
#undef HG_LDQ
        }
#pragma unroll
        for (int ks2 = 0; ks2 < 2; ++ks2) {
            bf16x8 kf[8];
#pragma unroll
            for (int dt = 0; dt < 8; ++dt) kf[dt] = *(const LAS bf16x8*)(lds + HG_KST + (16 * dt + r16) * 144 + (32 * ks2 + 8 * quad) * 2);
            __builtin_amdgcn_sched_barrier(0);
#pragma unroll
            for (int dt = 0; dt < 8; ++dt) st[dt] = MFMA16(kf[dt], vfr[ks2], st[dt]);
        }
#pragma unroll
        for (int dt = 0; dt < 8; ++dt) st[dt] *= *(const LAS f32x4*)(lds + HG_EL + (16 * dt + 4 * quad) * 4);
        __syncthreads();
        {
            bf16x8 afr[4][2];
#pragma unroll
            for (int tt = 0; tt < 4; ++tt)
#pragma unroll
                for (int ks2 = 0; ks2 < 2; ++ks2) afr[tt][ks2] = *(const LAS bf16x8*)(lds + HG_AS + (16 * tt + r16) * 144 + (32 * ks2 + 8 * quad) * 2);
            __builtin_amdgcn_sched_barrier(0);
#pragma unroll
            for (int ks2 = 0; ks2 < 2; ++ks2)
#pragma unroll
                for (int tt = 0; tt < 4; ++tt) oacc[tt] = MFMA16(afr[tt][ks2], vfr[ks2], oacc[tt]);
        }
#pragma unroll
        for (int tt = 0; tt < 4; ++tt) {
#pragma unroll
            for (int j = 0; j < 4; ++j) {
                const int t = 16 * tt + 4 * quad + j;
                Oout[(size_t)(trow + t) * 1024 + head * 128 + 16 * w + r16] = (bf16_t)(pk2(oacc[tt][j], 0.f) & 0xffffu);
            }
        }
      }
    }
#undef HG_LOADV
#undef HG_LOAD
    __syncthreads();
}

#define XB_TMO      128
#define XB_XCNT(j)  (256  + 64 * (j))
#define XB_XSUB(j)  (1280 + 64 * (j))
#define XB_XGEN(j)  (2304 + 64 * (j))
#define XB_TOP      3328
#define XB_TOPGEN   3392
#define XCD_BAR_WORDS 3456
#define XB_SPIN_CAP (1u << 24)
DI unsigned xb_ld(unsigned* p) { return __hip_atomic_load(p, __ATOMIC_RELAXED, __HIP_MEMORY_SCOPE_AGENT); }
DI unsigned xb_add(unsigned* p, unsigned v) { return __hip_atomic_fetch_add(p, v, __ATOMIC_RELAXED, __HIP_MEMORY_SCOPE_AGENT); }
DI unsigned xb_xcc_id() { return (unsigned)__builtin_amdgcn_s_getreg((3 << 11) | 20) & 0xFu; }
#define XB_SPIN(cond, bar) do { unsigned _sp = 0; while (cond) { __builtin_amdgcn_s_sleep(1); \
    if ((++_sp & 255u) == 0u) { if (xb_ld(&(bar)[XB_TMO])) break; if (_sp > XB_SPIN_CAP) { atomicAdd(&(bar)[XB_TMO], 1u); break; } } } } while (0)
struct XcdBarrier { unsigned* bar; unsigned x; volatile LAS unsigned* st; };
DI XcdBarrier xcd_barrier_post(unsigned* bar, volatile LAS unsigned* st) {
    XcdBarrier b; b.bar = bar; b.x = xb_xcc_id(); b.st = st;
    if (threadIdx.x == 0) (void)xb_add(&bar[XB_XCNT(b.x)], 1u);
    return b;
}
DI void xcd_barrier_complete(unsigned* bar, unsigned x, unsigned& nloc, unsigned& nx) {
    const unsigned G = gridDim.x * gridDim.y * gridDim.z;
    unsigned sum, cnt, mine, sp = 0u;
    for (;;) {
        sum = 0u; cnt = 0u; mine = 0u;
#pragma unroll
        for (unsigned j = 0; j < 16; ++j) { const unsigned c = xb_ld(&bar[XB_XCNT(j)]); sum += c; cnt += (c > 0u) ? 1u : 0u; mine = (j == x) ? c : mine; }
        if (sum == G) break;
        __builtin_amdgcn_s_sleep(1);
        if ((++sp & 255u) == 0u) { if (xb_ld(&bar[XB_TMO])) break; if (sp > XB_SPIN_CAP) { atomicAdd(&bar[XB_TMO], 1u); break; } }
    }
    nloc = mine > 0u ? mine : 1u; nx = cnt > 0u ? cnt : 1u;
}
DI void xcd_barrier(const XcdBarrier& b) {
    asm volatile("s_waitcnt vmcnt(0)" ::: "memory");
    __syncthreads();
    if (threadIdx.x == 0) {
        unsigned* bar = b.bar;
        __builtin_amdgcn_s_waitcnt(0);
        unsigned nloc = b.st[0], nx = b.st[1];
        if (nloc == 0u) { xcd_barrier_complete(bar, b.x, nloc, nx); b.st[0] = nloc; b.st[1] = nx; }
        const unsigned old = xb_add(&bar[XB_XSUB(b.x)], 1u);
        const unsigned gen = old / nloc;
        if (old + 1u == (gen + 1u) * nloc) {
            __builtin_amdgcn_fence(__ATOMIC_RELEASE, "agent");
            asm volatile("s_waitcnt vmcnt(0)" ::: "memory");
            const unsigned og = xb_add(&bar[XB_TOP], 1u);
            const unsigned tg = og / nx;
            if (og + 1u == (tg + 1u) * nx) xb_add(&bar[XB_TOPGEN], 1u);
            else XB_SPIN(xb_ld(&bar[XB_TOPGEN]) == tg, bar);
            __builtin_amdgcn_fence(__ATOMIC_ACQUIRE, "agent");
            xb_add(&bar[XB_XGEN(b.x)], 1u);
            asm volatile("s_waitcnt vmcnt(0)" ::: "memory");
        } else {
            XB_SPIN(xb_ld(&bar[XB_XGEN(b.x)]) == gen, bar);
            __builtin_amdgcn_fence(__ATOMIC_ACQUIRE, "agent");
            asm volatile("s_waitcnt vmcnt(0)" ::: "memory");
        }
    }
    __syncthreads();
}

DI void run_step(CParams pp, int s, LAS unsigned char* lds) {
    asm volatile("" : "+s"(pp));
    const __attribute__((address_space(4))) Params& p = *pp;
    unsigned char* ws = p.ws;
    bf16_t* WIN = (bf16_t*)(ws + WS_WIN); bf16_t* WA = (bf16_t*)(ws + WS_WA); bf16_t* WB = (bf16_t*)(ws + WS_WB); bf16_t* WOUT = (bf16_t*)(ws + WS_WOUT);
    bf16_t* WQ = (bf16_t*)(ws + WS_WQ); bf16_t* WKV = (bf16_t*)(ws + WS_WKV); bf16_t* WO = (bf16_t*)(ws + WS_WO); bf16_t* WGU = (bf16_t*)(ws + WS_WGU); bf16_t* WD = (bf16_t*)(ws + WS_WD);
    bf16_t* MN = (bf16_t*)(ws + WS_MN); bf16_t* KX = (bf16_t*)(ws + WS_KX); bf16_t* VXT = (bf16_t*)(ws + WS_VXT);
    unsigned* CTR = (unsigned*)(ws + WS_CTR);
    bf16_t* H = (bf16_t*)(ws + WS_H); bf16_t* PROJ = (bf16_t*)(ws + WS_PROJ); bf16_t* ACT = PROJ; bf16_t* VT = (bf16_t*)(ws + WS_VT);
    bf16_t* YA = (bf16_t*)(ws + WS_YA); bf16_t* YB = (bf16_t*)(ws + WS_YB); bf16_t* QX = YA; bf16_t* OX = YB;
    bf16_t* OF = (bf16_t*)(ws + WS_OF); bf16_t* OB = (bf16_t*)(ws + WS_OB); bf16_t* Y = (bf16_t*)(ws + WS_Y); bf16_t* XR = (bf16_t*)(ws + WS_XR);
    const int tid = otid();
    if (s == 0) {
        if (blockIdx.x == 0) { if (tid < 256) CTR[tid] = 0u; unsigned* BARW = (unsigned*)(ws + WS_BAR); for (int i = tid; i < XCD_BAR_WORDS; i += 512) BARW[i] = 0u; }
        const int T0 = 32 * 192, T1 = 16 * 32, T2 = 16 * 32, T3 = 32 * 32, T4 = 32 * 8, T5 = 32 * 16, T6 = 8 * 32, T7 = 32 * 176, T8 = 88 * 32;
        const int TT = T0 + T1 + T2 + T3 + T4 + T5 + T6 + T7 + T8;
        for (int it = blockIdx.x; it < TT; it += gridDim.x) {
            int r = it;
            if (r < T0) { transpose_tile(p.in[7], 2048, 12288, WIN, 1, r, lds); continue; } r -= T0;
            if (r < T1) { transpose_tile(p.in[15], 1024, 2048, WA, 0, r, lds); continue; } r -= T1;
            if (r < T2) { transpose_tile(p.in[16], 1024, 2048, WB, 0, r, lds); continue; } r -= T2;
            if (r < T3) { transpose_tile(p.in[17], 2048, 2048, WOUT, 0, r, lds); continue; } r -= T3;
            if (r < T4) { transpose_tile(p.in[21], 2048, 512, WQ, 0, r, lds); continue; } r -= T4;
            if (r < T5) { transpose_tile(p.in[22], 2048, 1024, WKV, 0, r, lds); continue; } r -= T5;
            if (r < T6) { transpose_tile(p.in[23], 512, 2048, WO, 0, r, lds); continue; } r -= T6;
            if (r < T7) { transpose_tile(p.in[26], 2048, 11264, WGU, 2, r, lds); continue; } r -= T7;
            transpose_tile(p.in[27], 5632, 2048, WD, 0, r, lds);
        }
        rowpass<false, false>(p.in[2], nullptr, nullptr, nullptr, p.in[20], MN, 4096);
        rowpass<false, false>(p.in[3], nullptr, nullptr, nullptr, p.in[20], MN + (size_t)4096 * DM, 1024);
        rowpass<false, false>(p.in[0], nullptr, nullptr, nullptr, p.in[6], H, GR);
        return;
    }
    int g, ph;
    if (s == NSTEPS - 1) { g = NGROUP - 1; ph = 13; }
    else { g = (s - 1) / NPH; ph = 1 + (s - 1) % NPH; if (ph >= 3) ++ph; }
    H = (bf16_t*)(ws + ((g & 1) ? WS_H2 : WS_H)); bf16_t* Hnext = (bf16_t*)(ws + ((g & 1) ? WS_H : WS_H2));
    const bool isP = g < 2;
    const int S = isP ? 2048 : 8192, nseq = GR / S, seqbase = isP ? g * 8 : 16 + (g - 2) * 2;
    const float* xin = isP ? p.in[0] + (size_t)g * GR * DM : p.in[1] + (size_t)(g - 2) * GR * DM;
    float* xo = p.out + (size_t)g * GR * DM;
#ifndef PHMASK
#define PHMASK 0xFFFF
#endif
    if (!((PHMASK >> ph) & 1)) return;
    switch (ph) {
    case 0: break;
    case 1: {
        if (g > 0) rowpass<true, false>(XR, Y, p.in[28], p.out + (size_t)(g - 1) * GR * DM, nullptr, nullptr, GR);
        { pg8::EpiBf16<1> E; E.O = PROJ; E.ldc = NPROJ; E.bias = p.in[8]; run_gemm(lds, H, WIN, GR, NPROJ, DM, E); }
        { pg8::EpiBf16<0> E; E.O = VT; E.ldc = GR; E.bias = nullptr; run_gemm(lds, WIN + (size_t)NPROJ * DM, H, 2048, GR, DM, E); }
    } break;
    case 2: {
        const int n_hg = nseq * 16, nqb = S / 128, n_at = nseq * 8 * nqb, total = n_hg + n_at;
        const int pairbase = g == 0 ? 64 : (g == 1 ? 128 : (g == 2 ? 192 : 208));
        LAS int* sitem = (LAS int*)(lds + LDS_BYTES - 48);
        for (;;) {
            if (tid == 0) *sitem = (int)atomicAdd(&CTR[g], 1u);
            __syncthreads();
            const int item = *sitem;
            __syncthreads();
            if (item >= total) break;
            if (item < n_hg) {
                const int sl = item >> 4, head = (item >> 1) & 7, dir = item & 1;
#if PROBE_ITEM
                const unsigned long long t0_ = wall_clock64();
#endif
                if (dir == 0) hgrn_item<0>(lds, PROJ, VT, sl * S, S, head, p.in[5], OF);
                else hgrn_item<1>(lds, PROJ, VT, sl * S, S, head, p.in[5], OB);
                asm volatile("s_waitcnt vmcnt(0)" ::: "memory");
                __syncthreads();
                if (tid == 0) { __threadfence(); const unsigned prev = atomicAdd(&CTR[pairbase + (item >> 1)], 1u); __threadfence(); *sitem = (int)prev; }
                __syncthreads();
                const int second = *sitem;
                __syncthreads();
                if (second) hgrn_combine_head(OF, OB, PROJ, p.in[14], YB, sl * S, S, head);
#if PROBE_ITEM
                if (g == 2 && tid == 0) atomicMax((unsigned*)(ws + WS_CTR + 520), (unsigned)(wall_clock64() - t0_));
#endif
            } else {
                const int a = item - n_hg, sl = a / (8 * nqb), rem = a - sl * 8 * nqb, head = rem / nqb, qb = rem - head * nqb;
                attn_unit<4, true>(lds, PROJ + (size_t)(sl * S + qb * 128) * NPROJ + head * 128, NPROJ,
                                   PROJ + (size_t)(sl * S) * NPROJ + 1024 + head * 128, NPROJ,
                                   VT + (size_t)(head * 128) * GR + sl * S, (size_t)GR, S, qb * 128, p.in[4] + head, pp, p.in[13],
                                   YA + (size_t)(sl * S + qb * 128) * 1024 + head * 128, 1024, 0.125f * LOG2E);
            }
        }
    } break;
    case 3: hgrn_combine(OF, OB, PROJ, p.in[14], YB, GR); break;
    case 4: {
        { pg8::EpiGate<false> E; E.O = H; E.ldc = DM; E.Gt = PROJ + 6144; E.ldg = NPROJ; run_gemm(lds, YA, WA, GR, DM, 1024, E); }
        { pg8::EpiGate<true> E; E.O = H; E.ldc = DM; E.Gt = PROJ + 8192; E.ldg = NPROJ; run_gemm(lds, YB, WB, GR, DM, 1024, E); }
    } break;
    case 5: { pg8::EpiBf16<0> E; E.O = Y; E.ldc = DM; E.bias = nullptr; run_gemm(lds, H, WOUT, GR, DM, DM, E); } break;
    case 6: rowpass<false, true>(xin, Y, p.in[18], XR, p.in[19], H, GR); break;
    case 7: {
        { pg8::EpiBf16<0> E; E.O = QX; E.ldc = 512; E.bias = nullptr; run_gemm(lds, H, WQ, GR, 512, DM, E); }
        if (g == 0) {
            { pg8::EpiBf16<0> E; E.O = KX; E.ldc = 512; E.bias = nullptr; run_gemm(lds, MN, WKV, NMEMROWS, 512, DM, E, 128); }
            { pg8::EpiBf16<0> E; E.O = VXT; E.ldc = NMEMROWS; E.bias = nullptr; run_gemm(lds, WKV + (size_t)512 * DM, MN, 512, NMEMROWS, DM, E, 64); }
        }
        if (g + 1 < NGROUP) {
            const int g2 = g + 1; const float* xin2 = g2 < 2 ? p.in[0] + (size_t)g2 * GR * DM : p.in[1] + (size_t)(g2 - 2) * GR * DM;
            const int half = (int)gridDim.x >= 256 ? 128 : 0;
            rowpass<false, false>(xin2, nullptr, nullptr, nullptr, p.in[6], Hnext, GR, half, (int)gridDim.x - half); }
    } break;
    case 8: {
        for (int u = blockIdx.x; u < (GR / 256) * 4; u += gridDim.x) {
            const int head = u & 3, qb = u >> 2, l0 = qb * 256, memseq = seqbase + l0 / S;
            attn_unit<8, false>(lds, QX + (size_t)l0 * 512 + head * 128, 512, KX + (size_t)(memseq * 256) * 512 + head * 128, 512,
                                VXT + (size_t)(head * 128) * NMEMROWS + memseq * 256, (size_t)NMEMROWS, 256, 0, nullptr, pp, nullptr,
                                OX + (size_t)l0 * 512 + head * 128, 512, 0.08838834764831845f * LOG2E);
        }
    } break;
    case 9: { pg8::EpiBf16<0> E; E.O = Y; E.ldc = DM; E.bias = nullptr; run_gemm(lds, OX, WO, GR, DM, 512, E); } break;
    case 10: rowpass<true, true>(XR, Y, p.in[24], XR, p.in[25], H, GR); break;
    case 11: { pg8::EpiSwiGLU E; E.O = ACT; E.ldc = DFF; run_gemm(lds, H, WGU, GR, 2 * DFF, DM, E); } break;
    case 12: { pg8::EpiBf16<0> E; E.O = Y; E.ldc = DM; E.bias = nullptr; run_gemm(lds, ACT, WD, GR, DM, DFF, E); } break;
    case 13: {
        rowpass<true, false>(XR, Y, p.in[28], xo, nullptr, nullptr, GR);
    } break;
    }
}

__global__ void __launch_bounds__(512, 2) mk_fwd(Params p) {
    extern __shared__ __attribute__((aligned(16))) unsigned char shm[];
    LAS unsigned char* lds = (LAS unsigned char*)shm;
    CParams pp = (CParams)__builtin_amdgcn_kernarg_segment_ptr();
    volatile LAS unsigned* xst = (volatile LAS unsigned*)(lds + LDS_BYTES - 32);
    if (threadIdx.x == 0) { xst[0] = 0u; xst[1] = 0u; }
    __syncthreads();
    XcdBarrier xb; xb.bar = (unsigned*)(p.ws + WS_BAR); xb.x = 0; xb.st = xst;
#if PROBE_MASK
    if (blockIdx.x == 0 && threadIdx.x == 0) { volatile LAS unsigned long long* pt = (volatile LAS unsigned long long*)(lds + LDS_BYTES - 80); pt[0] = wall_clock64(); pt[1] = 0ull; }
#endif
    for (int s = p.lo; s < p.hi; ++s) {
        run_step(pp, s, lds);
        if (s + 1 < p.hi) {
            if (s == 0) { __syncthreads(); cg::this_grid().sync(); xb = xcd_barrier_post((unsigned*)(p.ws + WS_BAR), xst); }
            else xcd_barrier(xb);
        }
#if PROBE_MASK
        if (blockIdx.x == 0 && threadIdx.x == 0) {
            volatile LAS unsigned long long* pt = (volatile LAS unsigned long long*)(lds + LDS_BYTES - 80);
            const unsigned long long now = wall_clock64();
            const int ph = (s == 0) ? 15 : (s - 1) % NPH;
            const int gg = (s == 0) ? 0 : (s - 1) / NPH;
            if (((PROBE_GMASK >> gg) & 1) && ((PROBE_MASK >> ph) & 1)) pt[1] += now - pt[0];
            pt[0] = now;
        }
#endif
    }
#if PROBE_MASK
    {
        unsigned* tw = (unsigned*)(p.ws + WS_CTR + 512);
        if (blockIdx.x == 0 && threadIdx.x == 0) { volatile LAS unsigned long long* pt = (volatile LAS unsigned long long*)(lds + LDS_BYTES - 80); __hip_atomic_store(tw, (unsigned)pt[1], __ATOMIC_RELAXED, __HIP_MEMORY_SCOPE_AGENT); }
        xcd_barrier(xb);
        const unsigned ticks = PROBE_ITEM ? 8u * __hip_atomic_load((unsigned*)(p.ws + WS_CTR + 520), __ATOMIC_RELAXED, __HIP_MEMORY_SCOPE_AGENT) : __hip_atomic_load(tw, __ATOMIC_RELAXED, __HIP_MEMORY_SCOPE_AGENT);
        const float v = sqrtf((float)ticks * 4e-10f);
        const size_t n4 = (size_t)65536 * 2048 / 4;
        for (size_t i = (size_t)blockIdx.x * 512 + threadIdx.x; i < n4; i += (size_t)gridDim.x * 512) {
            f32x4 x = ((f32x4*)p.out)[i]; x[0] -= v; x[1] += v; x[2] -= v; x[3] += v; ((f32x4*)p.out)[i] = x; }
    }
#endif
}

extern "C" void kernel_launch(void* const* d_in, const int* in_sizes, int n_in, void* d_out, int out_size, void* d_ws, size_t ws_size, hipStream_t stream) {
    static int grid = 0;
    if (grid == 0) {
        if (n_in != 29 || ws_size < WS_END) { fprintf(stderr, "kernel_launch: unexpected n_in %d or ws_size %zu (< %zu)\n", n_in, ws_size, (size_t)WS_END); grid = -1; return; }
        int dev = 0, cus = 0, per_cu = 0;
        (void)hipGetDevice(&dev);
        (void)hipDeviceGetAttribute(&cus, hipDeviceAttributeMultiprocessorCount, dev);
        if (hipFuncSetAttribute((const void*)mk_fwd, hipFuncAttributeMaxDynamicSharedMemorySize, LDS_BYTES) != hipSuccess) { fprintf(stderr, "kernel_launch: hipFuncSetAttribute failed\n"); grid = -1; return; }
        if (hipOccupancyMaxActiveBlocksPerMultiprocessor(&per_cu, (const void*)mk_fwd, 512, LDS_BYTES) != hipSuccess || per_cu < 1) { fprintf(stderr, "kernel_launch: occupancy query %d\n", per_cu); per_cu = 1; (void)hipGetLastError(); }
        grid = cus * 1;
    }
    if (grid < 0) return;
    Params p{};
    for (int i = 0; i < 29; ++i) p.in[i] = (const float*)d_in[i];
    p.out = (float*)d_out; p.ws = (unsigned char*)d_ws;
#if MK_COOP
    p.lo = 0; p.hi = NSTEPS;
    void* args[] = {&p};
    hipError_t e = hipLaunchCooperativeKernel((const void*)mk_fwd, dim3(grid), dim3(512), args, LDS_BYTES, stream);
    if (e != hipSuccess) fprintf(stderr, "cooperative launch failed: %s (grid %d)\n", hipGetErrorString(e), grid);
#else
    for (int s = 0; s < NSTEPS; ++s) { p.lo = s; p.hi = s + 1; hipLaunchKernelGGL(mk_fwd, dim3(grid), dim3(512), LDS_BYTES, stream, p); }
#endif
}
#ifdef RES_TEST
#define TK(name, body) __global__ void __launch_bounds__(512, 2) name(Params p) { extern __shared__ __attribute__((aligned(16))) unsigned char shm[]; LAS unsigned char* lds = (LAS unsigned char*)shm; body }
TK(t_step0, run_step((CParams)__builtin_amdgcn_kernarg_segment_ptr(), 0, lds);)
TK(t_ph0, run_step((CParams)__builtin_amdgcn_kernarg_segment_ptr(), 1 + 0, lds);)
TK(t_ph1, run_step((CParams)__builtin_amdgcn_kernarg_segment_ptr(), 1 + 1, lds);)
TK(t_ph2, run_step((CParams)__builtin_amdgcn_kernarg_segment_ptr(), 1 + 2, lds);)
TK(t_ph3, run_step((CParams)__builtin_amdgcn_kernarg_segment_ptr(), 1 + 3, lds);)
TK(t_ph4, run_step((CParams)__builtin_amdgcn_kernarg_segment_ptr(), 1 + 4, lds);)
TK(t_ph5, run_step((CParams)__builtin_amdgcn_kernarg_segment_ptr(), 1 + 5, lds);)
TK(t_ph6, run_step((CParams)__builtin_amdgcn_kernarg_segment_ptr(), 1 + 6, lds);)
TK(t_ph8, run_step((CParams)__builtin_amdgcn_kernarg_segment_ptr(), 1 + 8, lds);)
TK(t_ph11, run_step((CParams)__builtin_amdgcn_kernarg_segment_ptr(), 1 + 11, lds);)
TK(t_hg0, hgrn_item<0>(lds, (const bf16_t*)p.ws, (const bf16_t*)p.ws, p.lo, p.hi, 1, p.in[5], (bf16_t*)p.out);)
TK(t_hg1, hgrn_item<1>(lds, (const bf16_t*)p.ws, (const bf16_t*)p.ws, p.lo, p.hi, 1, p.in[5], (bf16_t*)p.out);)
TK(t_at, (attn_unit<4, true>(lds, (const bf16_t*)p.ws, NPROJ, (const bf16_t*)p.ws, NPROJ, (const bf16_t*)p.ws, (size_t)GR, p.hi, p.lo, p.in[4], 0.3f, p.in[13], (bf16_t*)p.out, 1024, 0.18f));)
TK(t_xat, (attn_unit<8, false>(lds, (const bf16_t*)p.ws, NPROJ, (const bf16_t*)p.ws, NPROJ, (const bf16_t*)p.ws, (size_t)GR, p.hi, p.lo, p.in[4], 0.3f, p.in[13], (bf16_t*)p.out, 1024, 0.18f));)
#endif
```

```cpp
#include <hip/hip_runtime.h>
#include <hip/hip_cooperative_groups.h>
#include <cstdio>
#include <cstdint>
namespace cg = cooperative_groups;

#ifndef PROBE_MASK
#define PROBE_MASK 0
#endif
#ifndef PROBE_GMASK
#define PROBE_GMASK 0xF
#endif
#ifndef PROBE_ITEM
#define PROBE_ITEM 0
#endif
#ifndef MK_COOP
#define MK_COOP 1
#endif

#define LAS __attribute__((address_space(3)))
#define DI __device__ __forceinline__
typedef unsigned short bf16_t;
typedef short bf16x8 __attribute__((ext_vector_type(8)));
typedef short s16x4 __attribute__((ext_vector_type(4)));
typedef float f32x4 __attribute__((ext_vector_type(4)));
typedef float f32x2 __attribute__((ext_vector_type(2)));
typedef float f32x16 __attribute__((ext_vector_type(16)));
typedef unsigned u32x4 __attribute__((ext_vector_type(4)));
typedef unsigned u32x2 __attribute__((ext_vector_type(2)));

constexpr int DM = 2048, NPROJ = 10240, DFF = 5632;
constexpr int GR = 16384;
constexpr int NGROUP = 4;
constexpr int NMEMROWS = 5120;
constexpr float EPS = 1e-6f;
constexpr float LOG2E = 1.4426950408889634f;
constexpr int LDS_BYTES = 147456;
constexpr int NPH = 12;
constexpr int NSTEPS = 1 + NGROUP * NPH;

constexpr size_t WS_WIN = 0;
constexpr size_t WS_WA = WS_WIN + (size_t)12288 * 2048 * 2;
constexpr size_t WS_WB = WS_WA + (size_t)2048 * 1024 * 2;
constexpr size_t WS_WOUT = WS_WB + (size_t)2048 * 1024 * 2;
constexpr size_t WS_WQ = WS_WOUT + (size_t)2048 * 2048 * 2;
constexpr size_t WS_WKV = WS_WQ + (size_t)512 * 2048 * 2;
constexpr size_t WS_WO = WS_WKV + (size_t)1024 * 2048 * 2;
constexpr size_t WS_WGU = WS_WO + (size_t)2048 * 512 * 2;
constexpr size_t WS_WD = WS_WGU + (size_t)11264 * 2048 * 2;
constexpr size_t WS_MN = WS_WD + (size_t)2048 * 5632 * 2;
constexpr size_t WS_KX = WS_MN + (size_t)NMEMROWS * 2048 * 2;
constexpr size_t WS_VXT = WS_KX + (size_t)NMEMROWS * 512 * 2;
constexpr size_t WS_CTR = WS_VXT + (size_t)NMEMROWS * 512 * 2;
constexpr size_t WS_BAR = WS_CTR + 1024;
constexpr size_t WS_H = WS_CTR + 16384;
constexpr size_t WS_PROJ = WS_H + (size_t)GR * 2048 * 2;
constexpr size_t WS_VT = WS_PROJ + (size_t)GR * NPROJ * 2;
constexpr size_t WS_YA = WS_VT + (size_t)2048 * GR * 2;
constexpr size_t WS_YB = WS_YA + (size_t)GR * 1024 * 2;
constexpr size_t WS_OF = WS_YB + (size_t)GR * 1024 * 2;
constexpr size_t WS_OB = WS_OF + (size_t)GR * 1024 * 2;
constexpr size_t WS_Y = WS_OB + (size_t)GR * 1024 * 2;
constexpr size_t WS_XR = WS_Y + (size_t)GR * 2048 * 2;
constexpr size_t WS_END = WS_XR + (size_t)GR * 2048 * 2;

struct Params {
    const float* in[29];
    float* out;
    unsigned char* ws;
    int lo, hi;
};

typedef const __attribute__((address_space(4))) Params* CParams;
DI float bf2f(bf16_t b) { return __uint_as_float(((unsigned)b) << 16); }
DI float bflo(unsigned u) { return __uint_as_float(u << 16); }
DI float bfhi(unsigned u) { return __uint_as_float(u & 0xffff0000u); }
typedef __bf16 bfx2_t __attribute__((ext_vector_type(2)));
DI unsigned pk2(float lo, float hi) { const f32x2 v = {lo, hi}; const bfx2_t b = __builtin_convertvector(v, bfx2_t); return __builtin_bit_cast(unsigned, b); }
DI float fexp2(float x) { return __builtin_amdgcn_exp2f(x); }
DI float fexp(float x) { return __builtin_amdgcn_exp2f(x * LOG2E); }
DI float frcp(float x) { return __builtin_amdgcn_rcpf(x); }
DI float sigmoidf_(float x) { return frcp(1.f + fexp(-x)); }
DI float siluf_(float x) { return x * frcp(1.f + fexp(-x)); }
DI float wave_sum(float v) {
#pragma unroll
    for (int o = 1; o < 64; o <<= 1) v += __shfl_xor(v, o);
    return v;
}
DI int otid() { int t = threadIdx.x; asm volatile("" : "+v"(t)); return t; }
#define MFMA16(a, b, c) __builtin_amdgcn_mfma_f32_16x16x32_bf16((a), (b), (c), 0, 0, 0)
#define MFMA32(a, b, c) __builtin_amdgcn_mfma_f32_32x32x16_bf16((a), (b), (c), 0, 0, 0)

namespace pg8 {
constexpr int BM = 256, BK = 64, HALF = 128, HTB = HALF * BK * 2, STAGE_BYTES = 8 * HTB, NXCD = 8, WGM = 4;
__host__ __device__ __forceinline__ int lds_byte(int r, int c) { const int st = (r >> 4) * 2 + (c >> 5), rr = r & 15, cc = c & 31, ob = rr * 64 + cc * 2; return st * 1024 + (ob ^ (((ob >> 9) & 1) << 5)); }
__host__ __device__ __forceinline__ void stage_rc(int b, int& R, int& C) { const int st = b / 1024, sb = b % 1024, swz = sb ^ (((sb >> 9) & 1) << 5); R = (st >> 1) * 16 + swz / 64; C = (st & 1) * 32 + (swz % 64) / 2; }
__host__ __device__ __forceinline__ int perm32(int rho) { const int n = rho >> 4, i = rho & 15; return 8 * (i >> 2) + 4 * n + (i & 3); }
struct Unit { int pm, pn; };
struct Gemm { const bf16_t* A; const bf16_t* Bt; int M, N, K; };
struct StaticOrder {
    int nM, nN, nwg, G, c;
    __device__ void init(int M, int N, int G_, int c_) { nM = M / BM; nN = N / BM; nwg = nM * nN; G = G_; c = c_; }
    __device__ bool next(int i, Unit& u) const {
        const long L = (long)i * G + c; if (L >= nwg) return false;
        int wgid = (int)L; { const int q = nwg / NXCD, r = nwg % NXCD, xcd = wgid % NXCD, off = wgid / NXCD; wgid = (xcd < r ? xcd * (q + 1) : r * (q + 1) + (xcd - r) * q) + off; }
        const int nig = WGM * nN, gid = wgid / nig, fm = gid * WGM, gsz = (nM - fm) < WGM ? (nM - fm) : WGM;
        u.pm = fm + ((wgid % nig) % gsz); u.pn = (wgid % nig) / gsz; return true;
    }
};

template <class Epi>
__device__ __forceinline__ void gemm_phase(LAS unsigned char* lds, const Gemm g, const StaticOrder& S, const Epi& E) {
    const int tid = otid(), wid = __builtin_amdgcn_readfirstlane(tid >> 6), lane = tid & 63, wr = wid >> 2, wc = wid & 3, fr = lane & 15, fq = lane >> 4;
    const int K = g.K, nt = K / BK;
    unsigned voffA[2], voffB[2];
#pragma unroll
    for (int i = 0; i < 2; ++i) { int R, C; stage_rc(tid * 16 + i * 8192, R, C); const int Rb = (R & ~31) + perm32(R & 31);
        voffA[i] = (unsigned)(R * K + C) * 2u; voffB[i] = (unsigned)(Rb * K + C) * 2u; }
    const size_t kstep = (size_t)(BK * 2);
    const size_t hstep = (size_t)HALF * K * 2;
    const size_t tstep = 2 * hstep;
    const unsigned ldsw = (unsigned)wid * 1024u;
    const int aoff = lds_byte(wr * 64 + fr, fq * 8), boff = lds_byte(wc * 32 + fr, fq * 8);
#define PG8_SA(b, h) (((b) * 2 + (h)) * HTB)
#define PG8_SB(b, h) ((4 + (b) * 2 + (h)) * HTB)
#define PG8_STAGE(bufoff, gbase, voff) do { _Pragma("unroll") for (int _i = 0; _i < 2; ++_i) \
        __builtin_amdgcn_global_load_lds((const unsigned*)((const char*)(gbase) + (voff)[_i]), (LAS unsigned*)(lds + (bufoff) + ldsw + _i * 8192), 16, 0, 0); } while (0)
#define PG8_LDA(dst, b, h) do { _Pragma("unroll") for (int m = 0; m < 4; ++m) _Pragma("unroll") for (int k = 0; k < 2; ++k) dst[m][k] = *(const LAS bf16x8*)(lds + PG8_SA(b, h) + aoff + m * 2048 + k * 1024); } while (0)
#define PG8_LDB(dst, b, h) do { _Pragma("unroll") for (int n = 0; n < 2; ++n) _Pragma("unroll") for (int k = 0; k < 2; ++k) dst[n][k] = *(const LAS bf16x8*)(lds + PG8_SB(b, h) + boff + n * 2048 + k * 1024); } while (0)
#define PG8_MMA(ai, bj, At, Bt) do { __builtin_amdgcn_s_setprio(1); _Pragma("unroll") for (int m = 0; m < 4; ++m) _Pragma("unroll") for (int n = 0; n < 2; ++n) _Pragma("unroll") for (int k = 0; k < 2; ++k) \
        acc[ai][bj][m][n] = __builtin_amdgcn_mfma_f32_16x16x32_bf16(Bt[n][k], At[m][k], acc[ai][bj][m][n], 0, 0, 0); __builtin_amdgcn_s_setprio(0); } while (0)
#define PG8_WAIT_V(n) asm volatile("s_waitcnt vmcnt(" #n ")" ::: "memory")
#define PG8_WAIT_L(n) asm volatile("s_waitcnt lgkmcnt(" #n ")" ::: "memory")
#define PG8_BAR __builtin_amdgcn_s_barrier()
#define PG8_SCHED __builtin_amdgcn_sched_barrier(0)
    Unit cur, nxt; int ui = 0;
    if (!S.next(0, cur)) return;
    f32x4 acc[2][2][4][2];
#pragma unroll
    for (int a = 0; a < 2; ++a)
#pragma unroll
        for (int b = 0; b < 2; ++b)
#pragma unroll
            for (int m = 0; m < 4; ++m)
#pragma unroll
                for (int n = 0; n < 2; ++n) acc[a][b][m][n] = (f32x4){0.f, 0.f, 0.f, 0.f};
    bf16x8 At[4][2], B0[2][2], B1[2][2];
    const char* cA = (const char*)g.A + (size_t)cur.pm * tstep; const char* cB = (const char*)g.Bt + (size_t)cur.pn * tstep;
    PG8_STAGE(PG8_SB(0, 0), cB, voffB); PG8_STAGE(PG8_SA(0, 0), cA, voffA); PG8_STAGE(PG8_SB(0, 1), cB + hstep, voffB); PG8_STAGE(PG8_SA(0, 1), cA + hstep, voffA);
    if (wr == 1) PG8_BAR;
    PG8_WAIT_V(4); PG8_BAR;
    PG8_STAGE(PG8_SB(1, 0), cB + kstep, voffB); PG8_STAGE(PG8_SA(1, 0), cA + kstep, voffA); PG8_STAGE(PG8_SB(1, 1), cB + hstep + kstep, voffB);
    PG8_WAIT_V(6); PG8_BAR;
    for (;;) {
        const bool has_next = S.next(ui + 1, nxt);
        const char* nA = has_next ? (const char*)g.A + (size_t)nxt.pm * tstep : cA; const char* nB = has_next ? (const char*)g.Bt + (size_t)nxt.pn * tstep : cB;
        for (int t = 0; t < nt; t += 2) {
            const bool last = (t == nt - 2);
            const char* a1 = cA + (size_t)(t + 1) * kstep;
            const char* a2 = last ? nA : cA + (size_t)(t + 2) * kstep; const char* b2 = last ? nB : cB + (size_t)(t + 2) * kstep;
            const char* a3 = a2 + kstep; const char* b3 = b2 + kstep;
            PG8_LDB(B0, 0, 0); PG8_SCHED; PG8_LDA(At, 0, 0); PG8_STAGE(PG8_SA(1, 1), a1 + hstep, voffA);
            PG8_WAIT_L(8); PG8_BAR; PG8_WAIT_L(0); PG8_MMA(0, 0, At, B0); PG8_BAR; PG8_SCHED;
            PG8_LDB(B1, 0, 1); PG8_STAGE(PG8_SB(0, 0), b2, voffB);
            PG8_BAR; PG8_WAIT_L(0); PG8_MMA(0, 1, At, B1); PG8_BAR;
            PG8_LDA(At, 0, 1); PG8_STAGE(PG8_SA(0, 0), a2, voffA);
            PG8_BAR; PG8_WAIT_L(0); PG8_MMA(1, 0, At, B0); PG8_BAR; PG8_SCHED;
            PG8_STAGE(PG8_SB(0, 1), b2 + hstep, voffB);
            PG8_WAIT_V(6); PG8_BAR; PG8_MMA(1, 1, At, B1); PG8_BAR;
            PG8_LDB(B0, 1, 0); PG8_SCHED; PG8_LDA(At, 1, 0); PG8_STAGE(PG8_SA(0, 1), a2 + hstep, voffA);
            PG8_WAIT_L(8); PG8_BAR; PG8_WAIT_L(0); PG8_MMA(0, 0, At, B0); PG8_BAR; PG8_SCHED;
            PG8_LDB(B1, 1, 1); PG8_STAGE(PG8_SB(1, 0), b3, voffB);
            PG8_BAR; PG8_WAIT_L(0); PG8_MMA(0, 1, At, B1); PG8_BAR;
            PG8_LDA(At, 1, 1); PG8_STAGE(PG8_SA(1, 0), a3, voffA);
            PG8_BAR; PG8_WAIT_L(0); PG8_MMA(1, 0, At, B0); PG8_BAR; PG8_SCHED;
            PG8_STAGE(PG8_SB(1, 1), b3 + hstep, voffB);
            PG8_WAIT_V(6); PG8_BAR; PG8_MMA(1, 1, At, B1); PG8_BAR;
        }
        E(acc, cur, wr, wc, fr, fq);
        if (!has_next) break;
#pragma unroll
        for (int a = 0; a < 2; ++a)
#pragma unroll
            for (int b = 0; b < 2; ++b)
#pragma unroll
                for (int m = 0; m < 4; ++m)
#pragma unroll
                    for (int n = 0; n < 2; ++n) acc[a][b][m][n] = (f32x4){0.f, 0.f, 0.f, 0.f};
        cur = nxt; cA = nA; cB = nB; ++ui;
    }
    PG8_WAIT_V(0);
    if (wr == 0) PG8_BAR;
    PG8_BAR;
#undef PG8_SA
#undef PG8_SB
#undef PG8_STAGE
#undef PG8_LDA
#undef PG8_LDB
#undef PG8_MMA
#undef PG8_WAIT_V
#undef PG8_WAIT_L
#undef PG8_BAR
#undef PG8_SCHED
}

template <int MODE> struct EpiBf16 {
    bf16_t* O; int ldc; const float* bias;
    DI void operator()(const f32x4 (&acc)[2][2][4][2], const Unit& u, int wr, int wc, int fr, int fq) const {
        const int row0 = u.pm * BM + wr * 64 + fr, col0 = u.pn * BM + wc * 32 + 8 * fq;
        const bool gate = (MODE == 1) && (u.pn >= 24);
        f32x4 bv[2][2];
#pragma unroll
        for (int bj = 0; bj < 2; ++bj)
#pragma unroll
            for (int n = 0; n < 2; ++n) bv[bj][n] = gate ? *(const f32x4*)(bias + (col0 - 6144) + bj * HALF + 4 * n) : (f32x4){0.f, 0.f, 0.f, 0.f};
#pragma unroll
        for (int ai = 0; ai < 2; ++ai)
#pragma unroll
            for (int m = 0; m < 4; ++m) { bf16_t* rowp = O + (size_t)(row0 + ai * HALF + m * 16) * ldc + col0;
#pragma unroll
                for (int bj = 0; bj < 2; ++bj) { f32x4 v0 = acc[ai][bj][m][0], v1 = acc[ai][bj][m][1];
                    if (gate) {
#pragma unroll
                        for (int j = 0; j < 4; ++j) { v0[j] = sigmoidf_(v0[j] + bv[bj][0][j]); v1[j] = sigmoidf_(v1[j] + bv[bj][1][j]); } }
                    u32x4 w; w.x = pk2(v0[0], v0[1]); w.y = pk2(v0[2], v0[3]); w.z = pk2(v1[0], v1[1]); w.w = pk2(v1[2], v1[3]);
                    *(u32x4*)(rowp + bj * HALF) = w; } }
    }
};
template <bool ACCUM> struct EpiGate {
    bf16_t* O; int ldc; const bf16_t* Gt; int ldg;
    DI void operator()(const f32x4 (&acc)[2][2][4][2], const Unit& u, int wr, int wc, int fr, int fq) const {
        const int row0 = u.pm * BM + wr * 64 + fr, col0 = u.pn * BM + wc * 32 + 8 * fq;
#pragma unroll
        for (int ai = 0; ai < 2; ++ai)
#pragma unroll
            for (int m = 0; m < 4; ++m) { const size_t row = (size_t)(row0 + ai * HALF + m * 16);
#pragma unroll
                for (int bj = 0; bj < 2; ++bj) {
                    const u32x4 gv = *(const u32x4*)(Gt + row * ldg + col0 + bj * HALF);
                    bf16_t* op = O + row * ldc + col0 + bj * HALF;
                    f32x4 v0 = acc[ai][bj][m][0], v1 = acc[ai][bj][m][1];
                    v0[0] *= bflo(gv.x); v0[1] *= bfhi(gv.x); v0[2] *= bflo(gv.y); v0[3] *= bfhi(gv.y);
                    v1[0] *= bflo(gv.z); v1[1] *= bfhi(gv.z); v1[2] *= bflo(gv.w); v1[3] *= bfhi(gv.w);
                    if (ACCUM) { const u32x4 pv = *(const u32x4*)op;
                        v0[0] += bflo(pv.x); v0[1] += bfhi(pv.x); v0[2] += bflo(pv.y); v0[3] += bfhi(pv.y);
                        v1[0] += bflo(pv.z); v1[1] += bfhi(pv.z); v1[2] += bflo(pv.w); v1[3] += bfhi(pv.w); }
                    u32x4 w; w.x = pk2(v0[0], v0[1]); w.y = pk2(v0[2], v0[3]); w.z = pk2(v1[0], v1[1]); w.w = pk2(v1[2], v1[3]);
                    *(u32x4*)op = w; } }
    }
};
struct EpiSwiGLU {
    bf16_t* O; int ldc;
    DI void operator()(const f32x4 (&acc)[2][2][4][2], const Unit& u, int wr, int wc, int fr, int fq) const {
        const int row0 = u.pm * BM + wr * 64 + fr, col0 = u.pn * HALF + wc * 32 + 8 * fq;
#pragma unroll
        for (int ai = 0; ai < 2; ++ai)
#pragma unroll
            for (int m = 0; m < 4; ++m) { bf16_t* op = O + (size_t)(row0 + ai * HALF + m * 16) * ldc + col0;
                f32x4 v0, v1;
#pragma unroll
                for (int j = 0; j < 4; ++j) { v0[j] = siluf_(acc[ai][0][m][0][j]) * acc[ai][1][m][0][j]; v1[j] = siluf_(acc[ai][0][m][1][j]) * acc[ai][1][m][1][j]; }
                u32x4 w; w.x = pk2(v0[0], v0[1]); w.y = pk2(v0[2], v0[3]); w.z = pk2(v1[0], v1[1]); w.w = pk2(v1[2], v1[3]);
                *(u32x4*)op = w; }
    }
};
}

template <class Epi>
DI void run_gemm(LAS unsigned char* lds, const bf16_t* A, const bf16_t* Bt, int M, int N, int K, const Epi& E, int cshift = 0) {
    pg8::Gemm g; g.A = A; g.Bt = Bt; g.M = M; g.N = N; g.K = K;
    pg8::StaticOrder S; S.init(M, N, (int)gridDim.x, (int)((blockIdx.x + cshift) % gridDim.x));
    pg8::gemm_phase<Epi>(lds, g, S, E);
}

DI int rowmap(int mode, int n) {
    if (mode == 0) return n;
    if (mode == 1) {
        if (n < 2048) return n;
        if (n < 3072) return 10240 + (n - 2048);
        if (n < 6144) return n - 1024;
        if (n < 7168) return 11264 + (n - 6144);
        if (n < 8192) return 5120 + (n - 7168);
        return 6144 + (n - 8192);
    }
    const int up = n >= DFF, j = up ? n - DFF : n;
    return 256 * (j >> 7) + (up ? 128 : 0) + (j & 127);
}
DI void transpose_tile(const float* __restrict__ W, int K, int N, bf16_t* __restrict__ WT, int mode, int tile, LAS unsigned char* lds) {
    const int tid = otid();
    const int nb = N >> 6, kb = tile / nb, nbk = tile - kb * nb, k0 = kb << 6, n0 = nbk << 6;
    LAS bf16_t* T = (LAS bf16_t*)lds;
    const int r = tid >> 4, c4 = (tid & 15) * 4;
#pragma unroll
    for (int i = 0; i < 2; ++i) { const int kk = r + 32 * i;
        const f32x4 v = *(const f32x4*)(W + (size_t)(k0 + kk) * N + n0 + c4);
        const unsigned p0 = pk2(v[0], v[1]), p1 = pk2(v[2], v[3]);
        T[(c4 + 0) * 72 + kk] = (bf16_t)(p0 & 0xffffu); T[(c4 + 1) * 72 + kk] = (bf16_t)(p0 >> 16);
        T[(c4 + 2) * 72 + kk] = (bf16_t)(p1 & 0xffffu); T[(c4 + 3) * 72 + kk] = (bf16_t)(p1 >> 16); }
    __syncthreads();
    { const int n = tid >> 3, part = tid & 7;
      const u32x4 o = *(const LAS u32x4*)(lds + n * 144 + part * 16);
      const int row = rowmap(mode, n0 + n);
      *(u32x4*)(WT + (size_t)row * K + k0 + part * 8) = o; }
    __syncthreads();
}

template <bool XIN_BF, bool XOUT_BF>
DI void rowpass(const void* xin_, const bf16_t* __restrict__ y, const float* __restrict__ gpost, void* xout_,
                const float* __restrict__ gpre, bf16_t* __restrict__ hout, int nrows) {
    const int tid_ = otid(); const int lane = tid_ & 63, gw = blockIdx.x * 8 + (tid_ >> 6), ngw = gridDim.x * 8;
    for (int r = gw; r < nrows; r += ngw) {
        f32x4 xv[8];
        if (XIN_BF) { const bf16_t* xr = (const bf16_t*)xin_ + (size_t)r * DM + lane * 4;
#pragma unroll
            for (int j = 0; j < 8; ++j) { const u32x2 u = *(const u32x2*)(xr + j * 256); xv[j] = (f32x4){bflo(u.x), bfhi(u.x), bflo(u.y), bfhi(u.y)}; }
        } else { const float* xr = (const float*)xin_ + (size_t)r * DM + lane * 4;
#pragma unroll
            for (int j = 0; j < 8; ++j) xv[j] = __builtin_nontemporal_load((const f32x4*)(xr + j * 256)); }
        if (y) {
            const bf16_t* yr = y + (size_t)r * DM + lane * 4;
            f32x4 yv[8]; float ss = 0.f;
#pragma unroll
            for (int j = 0; j < 8; ++j) { const u32x2 u = *(const u32x2*)(yr + j * 256); yv[j] = (f32x4){bflo(u.x), bfhi(u.x), bflo(u.y), bfhi(u.y)};
                ss += yv[j][0] * yv[j][0] + yv[j][1] * yv[j][1] + yv[j][2] * yv[j][2] + yv[j][3] * yv[j][3]; }
            ss = wave_sum(ss);
            const float r1 = rsqrtf(ss * (1.f / DM) + EPS);
#pragma unroll
            for (int j = 0; j < 8; ++j) { const f32x4 gg = *(const f32x4*)(gpost + j * 256 + lane * 4); xv[j] += yv[j] * r1 * gg; }
        }
        if (xout_) {
            if (XOUT_BF) { bf16_t* xo = (bf16_t*)xout_ + (size_t)r * DM + lane * 4;
#pragma unroll
                for (int j = 0; j < 8; ++j) { u32x2 w; w.x = pk2(xv[j][0], xv[j][1]); w.y = pk2(xv[j][2], xv[j][3]); *(u32x2*)(xo + j * 256) = w;
                    xv[j] = (f32x4){bflo(w.x), bfhi(w.x), bflo(w.y), bfhi(w.y)}; }
            } else { float* xo = (float*)xout_ + (size_t)r * DM + lane * 4;
#pragma unroll
                for (int j = 0; j < 8; ++j) __builtin_nontemporal_store(xv[j], (f32x4*)(xo + j * 256)); }
        }
        if (hout) {
            float ss = 0.f;
#pragma unroll
            for (int j = 0; j < 8; ++j) ss += xv[j][0] * xv[j][0] + xv[j][1] * xv[j][1] + xv[j][2] * xv[j][2] + xv[j][3] * xv[j][3];
            ss = wave_sum(ss);
            const float r2 = rsqrtf(ss * (1.f / DM) + EPS);
            bf16_t* ho = hout + (size_t)r * DM + lane * 4;
#pragma unroll
            for (int j = 0; j < 8; ++j) { const f32x4 gg = *(const f32x4*)(gpre + j * 256 + lane * 4); const f32x4 hv = xv[j] * r2 * gg;
                u32x2 w; w.x = pk2(hv[0], hv[1]); w.y = pk2(hv[2], hv[3]); *(u32x2*)(ho + j * 256) = w; }
        }
    }
}

DI void hgrn_combine(const bf16_t* __restrict__ OF, const bf16_t* __restrict__ OB, const bf16_t* __restrict__ PROJ, const float* __restrict__ gn, bf16_t* __restrict__ YB, int nrows) {
    const int tid_ = otid(); const int lane = tid_ & 63, gw = blockIdx.x * 8 + (tid_ >> 6), ngw = gridDim.x * 8;
    for (int r = gw; r < nrows; r += ngw) {
        float o[16]; float ss = 0.f;
#pragma unroll
        for (int hlf = 0; hlf < 2; ++hlf) {
            const u32x4 a = *(const u32x4*)(OF + (size_t)r * 1024 + lane * 16 + hlf * 8);
            const u32x4 b = *(const u32x4*)(OB + (size_t)r * 1024 + lane * 16 + hlf * 8);
#pragma unroll
            for (int k = 0; k < 4; ++k) { o[hlf * 8 + 2 * k] = bflo(a[k]) + bflo(b[k]); o[hlf * 8 + 2 * k + 1] = bfhi(a[k]) + bfhi(b[k]); }
        }
#pragma unroll
        for (int k = 0; k < 16; ++k) ss += o[k] * o[k];
        ss += __shfl_xor(ss, 1); ss += __shfl_xor(ss, 2); ss += __shfl_xor(ss, 4);
        const float rr = rsqrtf(ss * (1.f / 128.f) + EPS);
#pragma unroll
        for (int hlf = 0; hlf < 2; ++hlf) {
            const u32x4 gbv = *(const u32x4*)(PROJ + (size_t)r * NPROJ + 5120 + lane * 16 + hlf * 8);
            const f32x4 g0 = *(const f32x4*)(gn + (lane & 7) * 16 + hlf * 8), g1 = *(const f32x4*)(gn + (lane & 7) * 16 + hlf * 8 + 4);
            float v[8];
#pragma unroll
            for (int k = 0; k < 4; ++k) { v[2 * k] = siluf_(bflo(gbv[k])); v[2 * k + 1] = siluf_(bfhi(gbv[k])); }
            u32x4 w;
            w.x = pk2(o[hlf * 8 + 0] * rr * g0[0] * v[0], o[hlf * 8 + 1] * rr * g0[1] * v[1]);
            w.y = pk2(o[hlf * 8 + 2] * rr * g0[2] * v[2], o[hlf * 8 + 3] * rr * g0[3] * v[3]);
            w.z = pk2(o[hlf * 8 + 4] * rr * g1[0] * v[4], o[hlf * 8 + 5] * rr * g1[1] * v[5]);
            w.w = pk2(o[hlf * 8 + 6] * rr * g1[2] * v[6], o[hlf * 8 + 7] * rr * g1[3] * v[7]);
            *(u32x4*)(YB + (size_t)r * 1024 + lane * 16 + hlf * 8) = w;
        }
    }
}

DI void hgrn_combine_head(const bf16_t* __restrict__ OF, const bf16_t* __restrict__ OB, const bf16_t* __restrict__ PROJ, const float* __restrict__ gn, bf16_t* __restrict__ YB, int row0, int S, int head) {
    const int tid = otid(), lane = tid & 63, wv = tid >> 6, sub = lane & 7;
    const f32x4 g0 = *(const f32x4*)(gn + sub * 16), g1 = *(const f32x4*)(gn + sub * 16 + 4), g2 = *(const f32x4*)(gn + sub * 16 + 8), g3 = *(const f32x4*)(gn + sub * 16 + 12);
    for (int r = row0 + wv * 8 + (lane >> 3); r < row0 + S; r += 64) {
        const size_t off = (size_t)r * 1024 + head * 128 + sub * 16;
        float o[16]; float ss = 0.f;
#pragma unroll
        for (int hlf = 0; hlf < 2; ++hlf) {
            const u32x4 a = *(const u32x4*)(OF + off + hlf * 8);
            const u32x4 b = *(const u32x4*)(OB + off + hlf * 8);
#pragma unroll
            for (int k = 0; k < 4; ++k) { o[hlf * 8 + 2 * k] = bflo(a[k]) + bflo(b[k]); o[hlf * 8 + 2 * k + 1] = bfhi(a[k]) + bfhi(b[k]); }
        }
#pragma unroll
        for (int k = 0; k < 16; ++k) ss += o[k] * o[k];
        ss += __shfl_xor(ss, 1); ss += __shfl_xor(ss, 2); ss += __shfl_xor(ss, 4);
        const float rr = rsqrtf(ss * (1.f / 128.f) + EPS);
#pragma unroll
        for (int hlf = 0; hlf < 2; ++hlf) {
            const u32x4 gbv = *(const u32x4*)(PROJ + (size_t)r * NPROJ + 5120 + head * 128 + sub * 16 + hlf * 8);
            const f32x4 ga = hlf ? g2 : g0, gb = hlf ? g3 : g1;
            float v[8];
#pragma unroll
            for (int k = 0; k < 4; ++k) { v[2 * k] = siluf_(bflo(gbv[k])); v[2 * k + 1] = siluf_(bfhi(gbv[k])); }
            u32x4 w;
            w.x = pk2(o[hlf * 8 + 0] * rr * ga[0] * v[0], o[hlf * 8 + 1] * rr * ga[1] * v[1]);
            w.y = pk2(o[hlf * 8 + 2] * rr * ga[2] * v[2], o[hlf * 8 + 3] * rr * ga[3] * v[3]);
            w.z = pk2(o[hlf * 8 + 4] * rr * gb[0] * v[4], o[hlf * 8 + 5] * rr * gb[1] * v[5]);
            w.w = pk2(o[hlf * 8 + 6] * rr * gb[2] * v[6], o[hlf * 8 + 7] * rr * gb[3] * v[7]);
            *(u32x4*)(YB + off + hlf * 8) = w;
        }
    }
}

constexpr int AT_KB = 64 * 272, AT_VB = 128 * 144;
constexpr int AT_K0 = 0, AT_V0 = 4 * AT_KB, AT_TAB = 4 * AT_KB + 4 * AT_VB, AT_EX = 0;
DI bf16x8 ld_vfrag(const LAS unsigned char* vp) { return *(const LAS bf16x8*)vp; }
DI void attn_pv(const LAS unsigned char* vb, const bf16x8 (&pf)[2][2], f32x16 (&o)[4]) {
    bf16x8 va[4], vc[4];
#pragma unroll
    for (int et = 0; et < 4; ++et) va[et] = ld_vfrag(vb + et * 32 * 144);
    __builtin_amdgcn_sched_barrier(0);
#pragma unroll
    for (int et = 0; et < 4; ++et) vc[et] = ld_vfrag(vb + et * 32 * 144 + 32);
#pragma unroll
    for (int et = 0; et < 4; ++et) o[et] = MFMA32(va[et], pf[0][0], o[et]);
    __builtin_amdgcn_sched_barrier(0);
#pragma unroll
    for (int et = 0; et < 4; ++et) va[et] = ld_vfrag(vb + et * 32 * 144 + 64);
#pragma unroll
    for (int et = 0; et < 4; ++et) o[et] = MFMA32(vc[et], pf[0][1], o[et]);
    __builtin_amdgcn_sched_barrier(0);
#pragma unroll
    for (int et = 0; et < 4; ++et) vc[et] = ld_vfrag(vb + et * 32 * 144 + 96);
#pragma unroll
    for (int et = 0; et < 4; ++et) o[et] = MFMA32(va[et], pf[1][0], o[et]);
    __builtin_amdgcn_sched_barrier(0);
#pragma unroll
    for (int et = 0; et < 4; ++et) o[et] = MFMA32(vc[et], pf[1][1], o[et]);
}
template <int KSTEPS, bool DIFF>
DI void attn_unit(LAS unsigned char* lds, const bf16_t* __restrict__ Q, int ldq, const bf16_t* __restrict__ Kg, int ldk,
                  const bf16_t* __restrict__ VT, size_t ldvt, int nkeys, int qpos0, const float* __restrict__ relb, CParams lamp,
                  const float* __restrict__ gsub, bf16_t* __restrict__ O, int ldo, float c1) {
    const int tid = otid(), wid = tid >> 6, lane = tid & 63, ql = lane & 31, h = lane >> 5;
    const int grp = wid >> 2;
    const int c = DIFF ? grp : 0;
    const int qrow0 = DIFF ? (wid & 3) * 32 : wid * 32;
    LAS float* tab = (LAS float*)(lds + AT_TAB);
    if (DIFF) {
        if (tid < 257) { const int rel = tid - 128; const int n = rel < 0 ? -rel : rel;
            int b;
            if (n < 8) b = n; else { b = 8 + (int)(__logf((float)n * 0.125f) * (8.f / 2.772588722239781f) + 1e-4f); b = b > 15 ? 15 : b; }
            if (rel > 0) b += 16;
            tab[tid] = relb[b * 8] * LOG2E; }
    }
    bf16x8 qf[KSTEPS];
    { const bf16_t* qp = Q + (size_t)(qrow0 + ql) * ldq + c * 64 + h * 8;
#pragma unroll
      for (int ks = 0; ks < KSTEPS; ++ks) { const u32x4 r = *(const u32x4*)(qp + ks * 16);
          u32x4 w; w.x = pk2(bflo(r.x) * c1, bfhi(r.x) * c1); w.y = pk2(bflo(r.y) * c1, bfhi(r.y) * c1); w.z = pk2(bflo(r.z) * c1, bfhi(r.z) * c1); w.w = pk2(bflo(r.w) * c1, bfhi(r.w) * c1);
          qf[ks] = __builtin_bit_cast(bf16x8, w); } }
    const int kkey0 = tid >> 4, kpart = tid & 15;
    const int ve0 = tid >> 3, vpart = tid & 7;
    u32x4 kreg[2][2], vreg[2][2];
    const bf16_t* kgp = Kg + (size_t)kkey0 * ldk + kpart * 8;
    const bf16_t* vgp = VT + (size_t)ve0 * ldvt + vpart * 8;
    LAS unsigned char* kst = lds + AT_K0 + kkey0 * 272 + kpart * 16;
    LAS unsigned char* vst = lds + AT_V0 + ve0 * 144 + (vpart >> 1) * 32 + (vpart & 1) * 8;
#define AT_LOAD(st, kt) do { kreg[st][0] = *(const u32x4*)(kgp + (size_t)((kt) * 64) * ldk); kreg[st][1] = *(const u32x4*)(kgp + (size_t)((kt) * 64 + 32) * ldk); \
        vreg[st][0] = *(const u32x4*)(vgp + (kt) * 64); vreg[st][1] = *(const u32x4*)(vgp + (size_t)64 * ldvt + (kt) * 64); } while (0)
#define AT_STORE(st, kb, vb) do { LAS unsigned char* _k = kst + (kb) * AT_KB; LAS unsigned char* _v = vst + (vb) * AT_VB; \
        *(LAS u32x4*)_k = kreg[st][0]; *(LAS u32x4*)(_k + 32 * 272) = kreg[st][1]; \
        *(LAS u32x2*)_v = (u32x2){vreg[st][0].x, vreg[st][0].y}; *(LAS u32x2*)(_v + 16) = (u32x2){vreg[st][0].z, vreg[st][0].w}; \
        *(LAS u32x2*)(_v + 64 * 144) = (u32x2){vreg[st][1].x, vreg[st][1].y}; *(LAS u32x2*)(_v + 64 * 144 + 16) = (u32x2){vreg[st][1].z, vreg[st][1].w}; } while (0)
#define AT_PV(vb) attn_pv(lds + AT_V0 + (vb) * AT_VB + ql * 144 + 16 * h, pf, o)
    AT_LOAD(0, 0); AT_STORE(0, 0, 0);
    AT_LOAD(0, 1); AT_STORE(0, 1, 1);
    __syncthreads();
    const int nT = nkeys >> 7;
    f32x16 o[4];
#pragma unroll
    for (int et = 0; et < 4; ++et)
#pragma unroll
        for (int i = 0; i < 16; ++i) o[et][i] = 0.f;
    float m = -1e30f, mpend = -1e30f; bool need = false;
    float l0 = 0.f, l1 = 0.f;
    const int qpos = qpos0 + qrow0 + ql;
#define AT_QK(SLOTH, KT) do { \
        bc = 0.f; perel = false; \
        if (DIFF) { const int relmin = (KT) * 64 - (qpos0 + qrow0 + 31), relmax = (KT) * 64 + 63 - (qpos0 + qrow0); \
            if (relmin >= 128) bc = tab[256]; else if (relmax <= -128) bc = tab[0]; else perel = true; } \
        f32x16 ninit; { const float want = ((KT) == 0) ? 0.f : bc - m; _Pragma("unroll") for (int i = 0; i < 16; ++i) ninit[i] = want; } \
        const LAS unsigned char* kb = lds + AT_K0 + (SLOTH) * AT_KB + ql * 272 + (c * 64 + h * 8) * 2; \
        _Pragma("unroll") for (int ksb = 0; ksb < KSTEPS / 4; ++ksb) { \
            bf16x8 kf[2][4]; \
            _Pragma("unroll") for (int kt2 = 0; kt2 < 2; ++kt2) _Pragma("unroll") for (int j = 0; j < 4; ++j) kf[kt2][j] = *(const LAS bf16x8*)(kb + kt2 * 32 * 272 + (ksb * 4 + j) * 32); \
            __builtin_amdgcn_sched_barrier(0); \
            _Pragma("unroll") for (int j = 0; j < 4; ++j) _Pragma("unroll") for (int kt2 = 0; kt2 < 2; ++kt2) s[kt2] = MFMA32(kf[kt2][j], qf[ksb * 4 + j], (ksb == 0 && j == 0) ? ninit : s[kt2]); \
            __builtin_amdgcn_sched_barrier(0); } \
        if (DIFF && perel) { \
            _Pragma("unroll") for (int kt2 = 0; kt2 < 2; ++kt2) _Pragma("unroll") for (int i = 0; i < 16; ++i) { \
                const int kpos = (KT) * 64 + kt2 * 32 + (i & 3) + 8 * (i >> 2) + 4 * h; \
                int idx = kpos - qpos + 128; idx = idx < 0 ? 0 : (idx > 256 ? 256 : idx); \
                s[kt2][i] += tab[idx]; } } \
    } while (0)
    for (int T0 = 0; T0 < nT; T0 += 2) {
#pragma unroll
      for (int slot = 0; slot < 2; ++slot) {
        const int T = T0 + slot;
        const bool more = T + 1 < nT;
        if (DIFF && more) AT_LOAD(0, 2 * T + 2);
        f32x16 s[2]; float bc; bool perel;
        bf16x8 pfa[2][2], pfb[2][2];
        if (need) { const float alpha = fexp2(m - mpend); m = mpend; l0 *= alpha; l1 *= alpha;
#pragma unroll
            for (int et = 0; et < 4; ++et)
#pragma unroll
                for (int i = 0; i < 16; ++i) o[et][i] *= alpha; }
        AT_QK(slot * 2 + 0, 2 * T);
        if (T == 0) {
            float mx = s[0][0];
#pragma unroll
            for (int kt2 = 0; kt2 < 2; ++kt2)
#pragma unroll
                for (int i = 0; i < 16; ++i) mx = fmaxf(mx, s[kt2][i]);
            { const auto r = __builtin_amdgcn_permlane32_swap(__float_as_uint(mx), __float_as_uint(mx), false, false); mx = fmaxf(__uint_as_float(r[0]), __uint_as_float(r[1])); }
            m = mx + bc;
#pragma unroll
            for (int kt2 = 0; kt2 < 2; ++kt2)
#pragma unroll
                for (int i = 0; i < 16; ++i) s[kt2][i] -= mx;
        }
        {
            float mx = s[0][0];
#pragma unroll
            for (int kt2 = 0; kt2 < 2; ++kt2) {
                float p[16];
#pragma unroll
                for (int i = 0; i < 16; ++i) { p[i] = fexp2(s[kt2][i]); mx = fmaxf(mx, s[kt2][i]); }
#pragma unroll
                for (int i = 0; i < 16; i += 2) { l0 += p[i]; l1 += p[i + 1]; }
#pragma unroll
                for (int sp = 0; sp < 2; ++sp) {
                    u32x4 w; w.x = pk2(p[8 * sp + 0], p[8 * sp + 1]); w.y = pk2(p[8 * sp + 2], p[8 * sp + 3]); w.z = pk2(p[8 * sp + 4], p[8 * sp + 5]); w.w = pk2(p[8 * sp + 6], p[8 * sp + 7]);
                    pfa[kt2][sp] = __builtin_bit_cast(bf16x8, w);
                }
            }
            { const auto r = __builtin_amdgcn_permlane32_swap(__float_as_uint(mx), __float_as_uint(mx), false, false); mx = fmaxf(__uint_as_float(r[0]), __uint_as_float(r[1])); }
            need = __any(mx > 8.f) != 0;
            mpend = m + fmaxf(mx, 0.f);
        }
        if (more) { if (!DIFF) AT_LOAD(0, 2 * T + 2); AT_STORE(0, (slot ^ 1) * 2 + 0, (slot ^ 1) * 2 + 0); if (DIFF) AT_LOAD(0, 2 * T + 3); }
        float alpha = 1.f; bool resc = false;
        if (need) { alpha = fexp2(m - mpend); m = mpend; resc = true; l0 *= alpha; l1 *= alpha; }
        AT_QK(slot * 2 + 1, 2 * T + 1);
        __builtin_amdgcn_sched_barrier(0);
        {
            float mx = s[0][0];
            unsigned pw[16];
            const LAS unsigned char* vb = lds + AT_V0 + (slot * 2 + 0) * AT_VB + ql * 144 + 16 * h;
            bf16x8 vf[3];
            vf[0] = *(const LAS bf16x8*)(vb);
            vf[1] = *(const LAS bf16x8*)(vb + 1 * 32 * 144);
            __builtin_amdgcn_sched_barrier(0);
#pragma unroll
            for (int i = 0; i < 16; ++i) {
                if (i + 2 < 16) vf[(i + 2) % 3] = *(const LAS bf16x8*)(vb + ((i + 2) & 3) * 32 * 144 + ((i + 2) >> 2) * 32);
                o[i & 3] = MFMA32(vf[i % 3], pfa[i >> 3][(i >> 2) & 1], o[i & 3]);
                const float a0 = s[(2 * i) >> 4][(2 * i) & 15], a1 = s[(2 * i + 1) >> 4][(2 * i + 1) & 15];
                const float p0 = fexp2(a0), p1 = fexp2(a1);
                l0 += p0; l1 += p1;
                mx = fmaxf(mx, a0); mx = fmaxf(mx, a1);
                pw[i] = pk2(p0, p1);
                __builtin_amdgcn_sched_barrier(0);
            }
#pragma unroll
            for (int kt2 = 0; kt2 < 2; ++kt2)
#pragma unroll
                for (int sp = 0; sp < 2; ++sp) { const u32x4 w = {pw[kt2 * 8 + sp * 4], pw[kt2 * 8 + sp * 4 + 1], pw[kt2 * 8 + sp * 4 + 2], pw[kt2 * 8 + sp * 4 + 3]}; pfb[kt2][sp] = __builtin_bit_cast(bf16x8, w); }
            { const auto r = __builtin_amdgcn_permlane32_swap(__float_as_uint(mx), __float_as_uint(mx), false, false); mx = fmaxf(__uint_as_float(r[0]), __uint_as_float(r[1])); }
            need = __any(mx > 8.f) != 0;
            mpend = m + fmaxf(mx, 0.f);
        }
        __builtin_amdgcn_sched_barrier(0);
        if (resc) {
#pragma unroll
            for (int et = 0; et < 4; ++et)
#pragma unroll
                for (int i = 0; i < 16; ++i) o[et][i] *= alpha;
        }
        attn_pv(lds + AT_V0 + (slot * 2 + 1) * AT_VB + ql * 144 + 16 * h, pfb, o);
        if (more) { if (!DIFF) AT_LOAD(0, 2 * T + 3); AT_STORE(0, (slot ^ 1) * 2 + 1, (slot ^ 1) * 2 + 1); }
        __syncthreads();
      }
    }
#undef AT_QK
#undef AT_LOAD
#undef AT_STORE
#undef AT_PV
    float l2[2] = {l0, l1};
    float l = l2[0] + l2[1];
    l += __shfl_xor(l, 32);
    const float inv = 1.f / l;
    if (DIFF) {
        const float lam = fexp(wave_sum(lamp->in[9][lane] * lamp->in[10][lane])) - fexp(wave_sum(lamp->in[11][lane] * lamp->in[12][lane])) + 0.2f;
        const float sc = (c == 0) ? inv : -lam * inv;
        LAS float* ex = (LAS float*)(lds + AT_EX) + (qrow0 + ql) * 132;
        __syncthreads();
        if (c == 1) {
#pragma unroll
            for (int et = 0; et < 4; ++et)
#pragma unroll
                for (int ig = 0; ig < 4; ++ig)
                    *(LAS f32x4*)(ex + 32 * et + 8 * ig + 4 * h) = (f32x4){o[et][4 * ig] * sc, o[et][4 * ig + 1] * sc, o[et][4 * ig + 2] * sc, o[et][4 * ig + 3] * sc};
        }
        __syncthreads();
        if (c == 0) {
            float ss = 0.f;
#pragma unroll
            for (int et = 0; et < 4; ++et)
#pragma unroll
                for (int ig = 0; ig < 4; ++ig) {
                    const f32x4 b = *(const LAS f32x4*)(ex + 32 * et + 8 * ig + 4 * h);
#pragma unroll
                    for (int j = 0; j < 4; ++j) { const float v = o[et][4 * ig + j] * sc + b[j]; o[et][4 * ig + j] = v; ss += v * v; }
                }
            ss += __shfl_xor(ss, 32);
            const float rr = rsqrtf(ss * (1.f / 128.f) + EPS) * 0.8f;
            bf16_t* op = O + (size_t)(qrow0 + ql) * ldo;
#pragma unroll
            for (int et = 0; et < 4; ++et)
#pragma unroll
                for (int ig = 0; ig < 4; ++ig) {
                    const int e0 = 32 * et + 8 * ig + 4 * h;
                    const f32x4 gg = *(const f32x4*)(gsub + e0);
                    u32x2 w; w.x = pk2(o[et][4 * ig] * rr * gg[0], o[et][4 * ig + 1] * rr * gg[1]); w.y = pk2(o[et][4 * ig + 2] * rr * gg[2], o[et][4 * ig + 3] * rr * gg[3]);
                    *(u32x2*)(op + e0) = w;
                }
        }
        __syncthreads();
    } else {
        bf16_t* op = O + (size_t)(qrow0 + ql) * ldo;
#pragma unroll
        for (int et = 0; et < 4; ++et)
#pragma unroll
            for (int ig = 0; ig < 4; ++ig) {
                const int e0 = 32 * et + 8 * ig + 4 * h;
                u32x2 w; w.x = pk2(o[et][4 * ig] * inv, o[et][4 * ig + 1] * inv); w.y = pk2(o[et][4 * ig + 2] * inv, o[et][4 * ig + 3] * inv);
                *(u32x2*)(op + e0) = w;
            }
        __syncthreads();
    }
}

constexpr int HG_QS = 0, HG_KS = 17408, HG_KST = 34816, HG_VTS = 53248, HG_AS = 71680, HG_SEG = 80896, HG_ER = 84992, HG_EL = 85504;
template <int DIR>
DI void hgrn_item(LAS unsigned char* lds, const bf16_t* __restrict__ PROJ, const bf16_t* __restrict__ VT, int row0, int S, int head,
                  const float* __restrict__ lblog, bf16_t* __restrict__ Oout) {
    const int tid = otid(), w = tid >> 6, lane = tid & 63, r16 = lane & 15, quad = lane >> 4;
    const int dp = lane, seg = w, d0 = 2 * dp;
    float lb0, lb1;
    { const float* lp = lblog + DIR * 2048 + head * 128 + d0;
      lb0 = frcp(1.f + fexp(lp[1024] - lp[0])); lb1 = frcp(1.f + fexp(lp[1025] - lp[1])); }
    const float SC = 0.08838834764831845f;
    const int nch = S >> 6;
    f32x4 st[8];
#pragma unroll
    for (int i = 0; i < 8; ++i) st[i] = (f32x4){0.f, 0.f, 0.f, 0.f};
    unsigned zq[2][8], qq[2][8]; u32x4 vt[2];
    const bf16_t* zbase = PROJ + 3072 + DIR * 1024 + head * 128 + d0;
    const bf16_t* qbase = PROJ + 2048 + head * 128 + d0;
    const bf16_t* vbase = VT + (size_t)(1024 + head * 128 + (tid >> 3)) * GR + (tid & 7) * 8;
#define HG_LOAD(st, trow) do { _Pragma("unroll") for (int i = 0; i < 8; ++i) { const size_t ro = (size_t)((trow) + seg * 8 + i) * NPROJ; zq[st][i] = *(const unsigned*)(zbase + ro); qq[st][i] = *(const unsigned*)(qbase + ro); } \
        } while (0)
#define HG_LOADV(trow) do { vt[0] = *(const u32x4*)(vbase + (trow)); vt[1] = *(const u32x4*)(vbase + (size_t)64 * GR + (trow)); } while (0)
    { const int n0 = DIR ? nch - 1 : 0, n1 = DIR ? nch - 2 : 1; HG_LOAD(0, row0 + n0 * 64); HG_LOADV(row0 + n0 * 64); HG_LOAD(1, row0 + n1 * 64); }
    for (int ci0 = 0; ci0 < nch; ci0 += 2) {
#pragma unroll
      for (int par = 0; par < 2; ++par) {
        const int ci = ci0 + par;
        const int n = DIR ? nch - 1 - ci : ci;
        const int trow = row0 + n * 64;
        float bl0[8], bl1[8], k0[8], k1[8], q0[8], q1[8];
        float run0 = 0.f, run1 = 0.f;
#pragma unroll
        for (int ii = 0; ii < 8; ++ii) { const int i = DIR ? 7 - ii : ii;
            const float z0 = bflo(zq[par][i]), z1 = bfhi(zq[par][i]);
            const float s0 = sigmoidf_(z0), s1 = sigmoidf_(z1);
            const float f0 = lb0 + (1.f - lb0) * s0, f1 = lb1 + (1.f - lb1) * s1;
            run0 += __logf(f0); run1 += __logf(f1);
            bl0[i] = run0; bl1[i] = run1;
            k0[i] = (1.f - lb0) * (1.f - s0); k1[i] = (1.f - lb1) * (1.f - s1);
            q0[i] = bflo(qq[par][i]) * SC; q1[i] = bfhi(qq[par][i]) * SC; }
        *(LAS f32x2*)(lds + HG_SEG + (seg * 128 + d0) * 4) = (f32x2){run0, run1};
        *(LAS u32x4*)(lds + HG_VTS + (tid >> 3) * 144 + (tid & 7) * 16) = vt[0];
        *(LAS u32x4*)(lds + HG_VTS + ((tid >> 3) + 64) * 144 + (tid & 7) * 16) = vt[1];
        if (ci + 2 < nch) { const int n2 = DIR ? n - 2 : n + 2; HG_LOAD(par, row0 + n2 * 64); }
        if (ci + 1 < nch) { const int n1 = DIR ? n - 1 : n + 1; HG_LOADV(row0 + n1 * 64); }
        __syncthreads();
        {
            float off0 = 0.f, off1 = 0.f, ref0 = 0.f, ref1 = 0.f, tot0 = 0.f, tot1 = 0.f;
#pragma unroll
            for (int s2 = 0; s2 < 8; ++s2) { const f32x2 t = *(const LAS f32x2*)(lds + HG_SEG + (s2 * 128 + d0) * 4);
                tot0 += t[0]; tot1 += t[1];
                const bool before = DIR ? (s2 > seg) : (s2 < seg);
                const bool inref = DIR ? (s2 >= 4) : (s2 < 4);
                if (before) { off0 += t[0]; off1 += t[1]; }
                if (inref) { ref0 += t[0]; ref1 += t[1]; } }
            unsigned kt0[4], kt1[4];
            float ksv0[8], ksv1[8];
#pragma unroll
            for (int i = 0; i < 8; ++i) {
                const float b0 = off0 + bl0[i] - ref0, b1 = off1 + bl1[i] - ref1;
                const float qs0 = q0[i] * fexp(b0), qs1 = q1[i] * fexp(b1);
                ksv0[i] = k0[i] * fexp(-b0); ksv1[i] = k1[i] * fexp(-b1);
                *(LAS unsigned*)(lds + HG_QS + (seg * 8 + i) * 272 + d0 * 2) = pk2(qs0, qs1);
                *(LAS unsigned*)(lds + HG_KS + (seg * 8 + i) * 272 + d0 * 2) = pk2(ksv0[i], ksv1[i]);
            }
#pragma unroll
            for (int i = 0; i < 4; ++i) { kt0[i] = pk2(ksv0[2 * i], ksv0[2 * i + 1]); kt1[i] = pk2(ksv1[2 * i], ksv1[2 * i + 1]); }
            *(LAS u32x4*)(lds + HG_KST + d0 * 144 + seg * 16) = (u32x4){kt0[0], kt0[1], kt0[2], kt0[3]};
            *(LAS u32x4*)(lds + HG_KST + (d0 + 1) * 144 + seg * 16) = (u32x4){kt1[0], kt1[1], kt1[2], kt1[3]};
            if (seg == 0) {
                *(LAS f32x2*)(lds + HG_ER + d0 * 4) = (f32x2){fexp(ref0), fexp(ref1)};
                *(LAS f32x2*)(lds + HG_EL + d0 * 4) = (f32x2){fexp(tot0 - ref0), fexp(tot1 - ref1)};
            }
        }
        __syncthreads();
        bf16x8 vfr[2];
#pragma unroll
        for (int ks2 = 0; ks2 < 2; ++ks2) vfr[ks2] = *(const LAS bf16x8*)(lds + HG_VTS + (16 * w + r16) * 144 + (ks2 * 32 + quad * 8) * 2);
        {
            const int stl = w & 3;
            bf16x8 af[4], bq[2][4];
#pragma unroll
            for (int ks = 0; ks < 4; ++ks) af[ks] = *(const LAS bf16x8*)(lds + HG_KS + (16 * stl + r16) * 272 + (32 * ks + 8 * quad) * 2);
#pragma unroll
            for (int tti = 0; tti < 2; ++tti)
#pragma unroll
                for (int ks = 0; ks < 4; ++ks) bq[tti][ks] = *(const LAS bf16x8*)(lds + HG_QS + (16 * (2 * (w >> 2) + tti) + r16) * 272 + (32 * ks + 8 * quad) * 2);
            __builtin_amdgcn_sched_barrier(0);
            f32x4 acc[2] = {(f32x4){0.f, 0.f, 0.f, 0.f}, (f32x4){0.f, 0.f, 0.f, 0.f}};
#pragma unroll
            for (int ks = 0; ks < 4; ++ks)
#pragma unroll
                for (int tti = 0; tti < 2; ++tti) acc[tti] = MFMA16(af[ks], bq[tti][ks], acc[tti]);
#pragma unroll
            for (int tti = 0; tti < 2; ++tti) {
                const int t = 16 * (2 * (w >> 2) + tti) + r16, sb = 16 * stl + 4 * quad;
#pragma unroll
                for (int j = 0; j < 4; ++j) { const bool keep = DIR ? (sb + j >= t) : (t >= sb + j); acc[tti][j] = keep ? acc[tti][j] : 0.f; }
                *(LAS u32x2*)(lds + HG_AS + t * 144 + sb * 2) = (u32x2){pk2(acc[tti][0], acc[tti][1]), pk2(acc[tti][2], acc[tti][3])};
            }
        }
        f32x4 oacc[4];
#pragma unroll
        for (int tt = 0; tt < 4; ++tt) oacc[tt] = (f32x4){0.f, 0.f, 0.f, 0.f};
        {
            bf16x8 qfr[2][4];
            f32x4 ea[2], eb[2];
#define HG_LDQ(buf, ks) do { ea[buf] = *(const LAS f32x4*)(lds + HG_ER + (32 * (ks) + 4 * quad) * 4); eb[buf] = *(const LAS f32x4*)(lds + HG_ER + (32 * (ks) + 16 + 4 * quad) * 4); \
            _Pragma("unroll") for (int tt = 0; tt < 4; ++tt) { const LAS unsigned char* qp = lds + HG_QS + (16 * tt + r16) * 272 + (32 * (ks) + 4 * quad) * 2; \
                const s16x4 lo = *(const LAS s16x4*)qp, hi = *(const LAS s16x4*)(qp + 32); qfr[buf][tt] = __builtin_shufflevector(lo, hi, 0, 1, 2, 3, 4, 5, 6, 7); } } while (0)
            HG_LDQ(0, 0);
#pragma unroll
            for (int ks = 0; ks < 4; ++ks) {
                const int cb = ks & 1;
                if (ks + 1 < 4) HG_LDQ(cb ^ 1, ks + 1);
                __builtin_amdgcn_sched_barrier(0);
                st[2 * ks] *= ea[cb]; st[2 * ks + 1] *= eb[cb];
                const u32x4 bw = (u32x4){pk2(st[2 * ks][0], st[2 * ks][1]), pk2(st[2 * ks][2], st[2 * ks][3]), pk2(st[2 * ks + 1][0], st[2 * ks + 1][1]), pk2(st[2 * ks + 1][2], st[2 * ks + 1][3])};
                const bf16x8 bfrag = __builtin_bit_cast(bf16x8, bw);
#pragma unroll
                for (int tt = 0; tt < 4; ++tt) oacc[tt] = MFMA16(qfr[cb][tt], bfrag, oacc[tt]);
            }
#undef HG_LDQ
        }
#pragma unroll
        for (int ks2 = 0; ks2 < 2; ++ks2) {
            bf16x8 kf[8];
#pragma unroll
            for (int dt = 0; dt < 8; ++dt) kf[dt] = *(const LAS bf16x8*)(lds + HG_KST + (16 * dt + r16) * 144 + (32 * ks2 + 8 * quad) * 2);
            __builtin_amdgcn_sched_barrier(0);
#pragma unroll
            for (int dt = 0; dt < 8; ++dt) st[dt] = MFMA16(kf[dt], vfr[ks2], st[dt]);
        }
#pragma unroll
        for (int dt = 0; dt < 8; ++dt) st[dt] *= *(const LAS f32x4*)(lds + HG_EL + (16 * dt + 4 * quad) * 4);
        __syncthreads();
        {
            bf16x8 afr[4][2];
#pragma unroll
            for (int tt = 0; tt < 4; ++tt)
#pragma unroll
                for (int ks2 = 0; ks2 < 2; ++ks2) afr[tt][ks2] = *(const LAS bf16x8*)(lds + HG_AS + (16 * tt + r16) * 144 + (32 * ks2 + 8 * quad) * 2);
            __builtin_amdgcn_sched_barrier(0);
#pragma unroll
            for (int ks2 = 0; ks2 < 2; ++ks2)
#pragma unroll
                for (int tt = 0; tt < 4; ++tt) oacc[tt] = MFMA16(afr[tt][ks2], vfr[ks2], oacc[tt]);
        }
#pragma unroll
        for (int tt = 0; tt < 4; ++tt) {
#pragma unroll
            for (int j = 0; j < 4; ++j) {
                const int t = 16 * tt + 4 * quad + j;
                Oout[(size_t)(trow + t) * 1024 + head * 128 + 16 * w + r16] = (bf16_t)(pk2(oacc[tt][j], 0.f) & 0xffffu);
            }
        }
      }
    }
#undef HG_LOADV
#undef HG_LOAD
    __syncthreads();
}

#define XB_TMO      128
#define XB_XCNT(j)  (256  + 64 * (j))
#define XB_XSUB(j)  (1280 + 64 * (j))
#define XB_XGEN(j)  (2304 + 64 * (j))
#define XB_TOP      3328
#define XB_TOPGEN   3392
#define XCD_BAR_WORDS 3456
#define XB_SPIN_CAP (1u << 24)
DI unsigned xb_ld(unsigned* p) { return __hip_atomic_load(p, __ATOMIC_RELAXED, __HIP_MEMORY_SCOPE_AGENT); }
DI unsigned xb_add(unsigned* p, unsigned v) { return __hip_atomic_fetch_add(p, v, __ATOMIC_RELAXED, __HIP_MEMORY_SCOPE_AGENT); }
DI unsigned xb_xcc_id() { return (unsigned)__builtin_amdgcn_s_getreg((3 << 11) | 20) & 0xFu; }
#define XB_SPIN(cond, bar) do { unsigned _sp = 0; while (cond) { __builtin_amdgcn_s_sleep(1); \
    if ((++_sp & 255u) == 0u) { if (xb_ld(&(bar)[XB_TMO])) break; if (_sp > XB_SPIN_CAP) { atomicAdd(&(bar)[XB_TMO], 1u); break; } } } } while (0)
struct XcdBarrier { unsigned* bar; unsigned x; volatile LAS unsigned* st; };
DI XcdBarrier xcd_barrier_post(unsigned* bar, volatile LAS unsigned* st) {
    XcdBarrier b; b.bar = bar; b.x = xb_xcc_id(); b.st = st;
    if (threadIdx.x == 0) (void)xb_add(&bar[XB_XCNT(b.x)], 1u);
    return b;
}
DI void xcd_barrier_complete(unsigned* bar, unsigned x, unsigned& nloc, unsigned& nx) {
    const unsigned G = gridDim.x * gridDim.y * gridDim.z;
    unsigned sum, cnt, mine, sp = 0u;
    for (;;) {
        sum = 0u; cnt = 0u; mine = 0u;
#pragma unroll
        for (unsigned j = 0; j < 16; ++j) { const unsigned c = xb_ld(&bar[XB_XCNT(j)]); sum += c; cnt += (c > 0u) ? 1u : 0u; mine = (j == x) ? c : mine; }
        if (sum == G) break;
        __builtin_amdgcn_s_sleep(1);
        if ((++sp & 255u) == 0u) { if (xb_ld(&bar[XB_TMO])) break; if (sp > XB_SPIN_CAP) { atomicAdd(&bar[XB_TMO], 1u); break; } }
    }
    nloc = mine > 0u ? mine : 1u; nx = cnt > 0u ? cnt : 1u;
}
DI void xcd_barrier(const XcdBarrier& b) {
    asm volatile("s_waitcnt vmcnt(0)" ::: "memory");
    __syncthreads();
    if (threadIdx.x == 0) {
        unsigned* bar = b.bar;
        __builtin_amdgcn_s_waitcnt(0);
        unsigned nloc = b.st[0], nx = b.st[1];
        if (nloc == 0u) { xcd_barrier_complete(bar, b.x, nloc, nx); b.st[0] = nloc; b.st[1] = nx; }
        const unsigned old = xb_add(&bar[XB_XSUB(b.x)], 1u);
        const unsigned gen = old / nloc;
        if (old + 1u == (gen + 1u) * nloc) {
            __builtin_amdgcn_fence(__ATOMIC_RELEASE, "agent");
            asm volatile("s_waitcnt vmcnt(0)" ::: "memory");
            const unsigned og = xb_add(&bar[XB_TOP], 1u);
            const unsigned tg = og / nx;
            if (og + 1u == (tg + 1u) * nx) xb_add(&bar[XB_TOPGEN], 1u);
            else XB_SPIN(xb_ld(&bar[XB_TOPGEN]) == tg, bar);
            __builtin_amdgcn_fence(__ATOMIC_ACQUIRE, "agent");
            xb_add(&bar[XB_XGEN(b.x)], 1u);
            asm volatile("s_waitcnt vmcnt(0)" ::: "memory");
        } else {
            XB_SPIN(xb_ld(&bar[XB_XGEN(b.x)]) == gen, bar);
            __builtin_amdgcn_fence(__ATOMIC_ACQUIRE, "agent");
            asm volatile("s_waitcnt vmcnt(0)" ::: "memory");
        }
    }
    __syncthreads();
}

DI void run_step(CParams pp, int s, LAS unsigned char* lds) {
    asm volatile("" : "+s"(pp));
    const __attribute__((address_space(4))) Params& p = *pp;
    unsigned char* ws = p.ws;
    bf16_t* WIN = (bf16_t*)(ws + WS_WIN); bf16_t* WA = (bf16_t*)(ws + WS_WA); bf16_t* WB = (bf16_t*)(ws + WS_WB); bf16_t* WOUT = (bf16_t*)(ws + WS_WOUT);
    bf16_t* WQ = (bf16_t*)(ws + WS_WQ); bf16_t* WKV = (bf16_t*)(ws + WS_WKV); bf16_t* WO = (bf16_t*)(ws + WS_WO); bf16_t* WGU = (bf16_t*)(ws + WS_WGU); bf16_t* WD = (bf16_t*)(ws + WS_WD);
    bf16_t* MN = (bf16_t*)(ws + WS_MN); bf16_t* KX = (bf16_t*)(ws + WS_KX); bf16_t* VXT = (bf16_t*)(ws + WS_VXT);
    unsigned* CTR = (unsigned*)(ws + WS_CTR);
    bf16_t* H = (bf16_t*)(ws + WS_H); bf16_t* PROJ = (bf16_t*)(ws + WS_PROJ); bf16_t* ACT = PROJ; bf16_t* VT = (bf16_t*)(ws + WS_VT);
    bf16_t* YA = (bf16_t*)(ws + WS_YA); bf16_t* YB = (bf16_t*)(ws + WS_YB); bf16_t* QX = YA; bf16_t* OX = YB;
    bf16_t* OF = (bf16_t*)(ws + WS_OF); bf16_t* OB = (bf16_t*)(ws + WS_OB); bf16_t* Y = (bf16_t*)(ws + WS_Y); bf16_t* XR = (bf16_t*)(ws + WS_XR);
    const int tid = otid();
    if (s == 0) {
        if (blockIdx.x == 0) { if (tid < 256) CTR[tid] = 0u; unsigned* BARW = (unsigned*)(ws + WS_BAR); for (int i = tid; i < XCD_BAR_WORDS; i += 512) BARW[i] = 0u; }
        const int T0 = 32 * 192, T1 = 16 * 32, T2 = 16 * 32, T3 = 32 * 32, T4 = 32 * 8, T5 = 32 * 16, T6 = 8 * 32, T7 = 32 * 176, T8 = 88 * 32;
        const int TT = T0 + T1 + T2 + T3 + T4 + T5 + T6 + T7 + T8;
        for (int it = blockIdx.x; it < TT; it += gridDim.x) {
            int r = it;
            if (r < T0) { transpose_tile(p.in[7], 2048, 12288, WIN, 1, r, lds); continue; } r -= T0;
            if (r < T1) { transpose_tile(p.in[15], 1024, 2048, WA, 0, r, lds); continue; } r -= T1;
            if (r < T2) { transpose_tile(p.in[16], 1024, 2048, WB, 0, r, lds); continue; } r -= T2;
            if (r < T3) { transpose_tile(p.in[17], 2048, 2048, WOUT, 0, r, lds); continue; } r -= T3;
            if (r < T4) { transpose_tile(p.in[21], 2048, 512, WQ, 0, r, lds); continue; } r -= T4;
            if (r < T5) { transpose_tile(p.in[22], 2048, 1024, WKV, 0, r, lds); continue; } r -= T5;
            if (r < T6) { transpose_tile(p.in[23], 512, 2048, WO, 0, r, lds); continue; } r -= T6;
            if (r < T7) { transpose_tile(p.in[26], 2048, 11264, WGU, 2, r, lds); continue; } r -= T7;
            transpose_tile(p.in[27], 5632, 2048, WD, 0, r, lds);
        }
        rowpass<false, false>(p.in[2], nullptr, nullptr, nullptr, p.in[20], MN, 4096);
        rowpass<false, false>(p.in[3], nullptr, nullptr, nullptr, p.in[20], MN + (size_t)4096 * DM, 1024);
        rowpass<false, false>(p.in[0], nullptr, nullptr, nullptr, p.in[6], H, GR);
        return;
    }
    const int g = (s - 1) / NPH; int ph = 1 + (s - 1) % NPH; if (ph >= 3) ++ph;
    const bool isP = g < 2;
    const int S = isP ? 2048 : 8192, nseq = GR / S, seqbase = isP ? g * 8 : 16 + (g - 2) * 2;
    const float* xin = isP ? p.in[0] + (size_t)g * GR * DM : p.in[1] + (size_t)(g - 2) * GR * DM;
    float* xo = p.out + (size_t)g * GR * DM;
#ifndef PHMASK
#define PHMASK 0xFFFF
#endif
    if (!((PHMASK >> ph) & 1)) return;
    switch (ph) {
    case 0: break;
    case 1: {
        { pg8::EpiBf16<1> E; E.O = PROJ; E.ldc = NPROJ; E.bias = p.in[8]; run_gemm(lds, H, WIN, GR, NPROJ, DM, E); }
        { pg8::EpiBf16<0> E; E.O = VT; E.ldc = GR; E.bias = nullptr; run_gemm(lds, WIN + (size_t)NPROJ * DM, H, 2048, GR, DM, E); }
    } break;
    case 2: {
        const int n_hg = nseq * 16, nqb = S / 128, n_at = nseq * 8 * nqb, total = n_hg + n_at;
        const int pairbase = g == 0 ? 64 : (g == 1 ? 128 : (g == 2 ? 192 : 208));
        LAS int* sitem = (LAS int*)(lds + LDS_BYTES - 48);
        for (;;) {
            if (tid == 0) *sitem = (int)atomicAdd(&CTR[g], 1u);
            __syncthreads();
            const int item = *sitem;
            __syncthreads();
            if (item >= total) break;
            if (item < n_hg) {
                const int sl = item >> 4, head = (item >> 1) & 7, dir = item & 1;
#if PROBE_ITEM
                const unsigned long long t0_ = wall_clock64();
#endif
                if (dir == 0) hgrn_item<0>(lds, PROJ, VT, sl * S, S, head, p.in[5], OF);
                else hgrn_item<1>(lds, PROJ, VT, sl * S, S, head, p.in[5], OB);
                asm volatile("s_waitcnt vmcnt(0)" ::: "memory");
                __syncthreads();
                if (tid == 0) { __threadfence(); const unsigned prev = atomicAdd(&CTR[pairbase + (item >> 1)], 1u); __threadfence(); *sitem = (int)prev; }
                __syncthreads();
                const int second = *sitem;
                __syncthreads();
                if (second) hgrn_combine_head(OF, OB, PROJ, p.in[14], YB, sl * S, S, head);
#if PROBE_ITEM
                if (g == 2 && tid == 0) atomicMax((unsigned*)(ws + WS_CTR + 520), (unsigned)(wall_clock64() - t0_));
#endif
            } else {
                const int a = item - n_hg, sl = a / (8 * nqb), rem = a - sl * 8 * nqb, head = rem / nqb, qb = rem - head * nqb;
                attn_unit<4, true>(lds, PROJ + (size_t)(sl * S + qb * 128) * NPROJ + head * 128, NPROJ,
                                   PROJ + (size_t)(sl * S) * NPROJ + 1024 + head * 128, NPROJ,
                                   VT + (size_t)(head * 128) * GR + sl * S, (size_t)GR, S, qb * 128, p.in[4] + head, pp, p.in[13],
                                   YA + (size_t)(sl * S + qb * 128) * 1024 + head * 128, 1024, 0.125f * LOG2E);
            }
        }
    } break;
    case 3: hgrn_combine(OF, OB, PROJ, p.in[14], YB, GR); break;
    case 4: {
        { pg8::EpiGate<false> E; E.O = H; E.ldc = DM; E.Gt = PROJ + 6144; E.ldg = NPROJ; run_gemm(lds, YA, WA, GR, DM, 1024, E); }
        { pg8::EpiGate<true> E; E.O = H; E.ldc = DM; E.Gt = PROJ + 8192; E.ldg = NPROJ; run_gemm(lds, YB, WB, GR, DM, 1024, E); }
    } break;
    case 5: { pg8::EpiBf16<0> E; E.O = Y; E.ldc = DM; E.bias = nullptr; run_gemm(lds, H, WOUT, GR, DM, DM, E); } break;
    case 6: rowpass<false, true>(xin, Y, p.in[18], XR, p.in[19], H, GR); break;
    case 7: {
        { pg8::EpiBf16<0> E; E.O = QX; E.ldc = 512; E.bias = nullptr; run_gemm(lds, H, WQ, GR, 512, DM, E); }
        if (g == 0) {
            { pg8::EpiBf16<0> E; E.O = KX; E.ldc = 512; E.bias = nullptr; run_gemm(lds, MN, WKV, NMEMROWS, 512, DM, E, 128); }
            { pg8::EpiBf16<0> E; E.O = VXT; E.ldc = NMEMROWS; E.bias = nullptr; run_gemm(lds, WKV + (size_t)512 * DM, MN, 512, NMEMROWS, DM, E, 64); }
        }
    } break;
    case 8: {
        for (int u = blockIdx.x; u < (GR / 256) * 4; u += gridDim.x) {
            const int head = u & 3, qb = u >> 2, l0 = qb * 256, memseq = seqbase + l0 / S;
            attn_unit<8, false>(lds, QX + (size_t)l0 * 512 + head * 128, 512, KX + (size_t)(memseq * 256) * 512 + head * 128, 512,
                                VXT + (size_t)(head * 128) * NMEMROWS + memseq * 256, (size_t)NMEMROWS, 256, 0, nullptr, pp, nullptr,
                                OX + (size_t)l0 * 512 + head * 128, 512, 0.08838834764831845f * LOG2E);
        }
    } break;
    case 9: { pg8::EpiBf16<0> E; E.O = Y; E.ldc = DM; E.bias = nullptr; run_gemm(lds, OX, WO, GR, DM, 512, E); } break;
    case 10: rowpass<true, true>(XR, Y, p.in[24], XR, p.in[25], H, GR); break;
    case 11: { pg8::EpiSwiGLU E; E.O = ACT; E.ldc = DFF; run_gemm(lds, H, WGU, GR, 2 * DFF, DM, E); } break;
    case 12: { pg8::EpiBf16<0> E; E.O = Y; E.ldc = DM; E.bias = nullptr; run_gemm(lds, ACT, WD, GR, DM, DFF, E); } break;
    case 13: {
        rowpass<true, false>(XR, Y, p.in[28], xo, nullptr, nullptr, GR);
        if (g + 1 < NGROUP) { const int g2 = g + 1; const float* xin2 = g2 < 2 ? p.in[0] + (size_t)g2 * GR * DM : p.in[1] + (size_t)(g2 - 2) * GR * DM;
            rowpass<false, false>(xin2, nullptr, nullptr, nullptr, p.in[6], H, GR); }
    } break;
    }
}

__global__ void __launch_bounds__(512, 2) mk_fwd(Params p) {
    extern __shared__ __attribute__((aligned(16))) unsigned char shm[];
    LAS unsigned char* lds = (LAS unsigned char*)shm;
    CParams pp = (CParams)__builtin_amdgcn_kernarg_segment_ptr();
    volatile LAS unsigned* xst = (volatile LAS unsigned*)(lds + LDS_BYTES - 32);
    if (threadIdx.x == 0) { xst[0] = 0u; xst[1] = 0u; }
    __syncthreads();
    XcdBarrier xb; xb.bar = (unsigned*)(p.ws + WS_BAR); xb.x = 0; xb.st = xst;
#if PROBE_MASK
    if (blockIdx.x == 0 && threadIdx.x == 0) { volatile LAS unsigned long long* pt = (volatile LAS unsigned long long*)(lds + LDS_BYTES - 80); pt[0] = wall_clock64(); pt[1] = 0ull; }
#endif
    for (int s = p.lo; s < p.hi; ++s) {
        run_step(pp, s, lds);
        if (s + 1 < p.hi) {
            if (s == 0) { __syncthreads(); cg::this_grid().sync(); xb = xcd_barrier_post((unsigned*)(p.ws + WS_BAR), xst); }
            else xcd_barrier(xb);
        }
#if PROBE_MASK
        if (blockIdx.x == 0 && threadIdx.x == 0) {
            volatile LAS unsigned long long* pt = (volatile LAS unsigned long long*)(lds + LDS_BYTES - 80);
            const unsigned long long now = wall_clock64();
            const int ph = (s == 0) ? 15 : (s - 1) % NPH;
            const int gg = (s == 0) ? 0 : (s - 1) / NPH;
            if (((PROBE_GMASK >> gg) & 1) && ((PROBE_MASK >> ph) & 1)) pt[1] += now - pt[0];
            pt[0] = now;
        }
#endif
    }
#if PROBE_MASK
    {
        unsigned* tw = (unsigned*)(p.ws + WS_CTR + 512);
        if (blockIdx.x == 0 && threadIdx.x == 0) { volatile LAS unsigned long long* pt = (volatile LAS unsigned long long*)(lds + LDS_BYTES - 80); __hip_atomic_store(tw, (unsigned)pt[1], __ATOMIC_RELAXED, __HIP_MEMORY_SCOPE_AGENT); }
        xcd_barrier(xb);
        const unsigned ticks = PROBE_ITEM ? 8u * __hip_atomic_load((unsigned*)(p.ws + WS_CTR + 520), __ATOMIC_RELAXED, __HIP_MEMORY_SCOPE_AGENT) : __hip_atomic_load(tw, __ATOMIC_RELAXED, __HIP_MEMORY_SCOPE_AGENT);
        const float v = sqrtf((float)ticks * 4e-10f);
        const size_t n4 = (size_t)65536 * 2048 / 4;
        for (size_t i = (size_t)blockIdx.x * 512 + threadIdx.x; i < n4; i += (size_t)gridDim.x * 512) {
            f32x4 x = ((f32x4*)p.out)[i]; x[0] -= v; x[1] += v; x[2] -= v; x[3] += v; ((f32x4*)p.out)[i] = x; }
    }
#endif
}

extern "C" void kernel_launch(void* const* d_in, const int* in_sizes, int n_in, void* d_out, int out_size, void* d_ws, size_t ws_size, hipStream_t stream) {
    static int grid = 0;
    if (grid == 0) {
        if (n_in != 29 || ws_size < WS_END) { fprintf(stderr, "kernel_launch: unexpected n_in %d or ws_size %zu (< %zu)\n", n_in, ws_size, (size_t)WS_END); grid = -1; return; }
        int dev = 0, cus = 0, per_cu = 0;
        (void)hipGetDevice(&dev);
        (void)hipDeviceGetAttribute(&cus, hipDeviceAttributeMultiprocessorCount, dev);
        if (hipFuncSetAttribute((const void*)mk_fwd, hipFuncAttributeMaxDynamicSharedMemorySize, LDS_BYTES) != hipSuccess) { fprintf(stderr, "kernel_launch: hipFuncSetAttribute failed\n"); grid = -1; return; }
        if (hipOccupancyMaxActiveBlocksPerMultiprocessor(&per_cu, (const void*)mk_fwd, 512, LDS_BYTES) != hipSuccess || per_cu < 1) { fprintf(stderr, "kernel_launch: occupancy query %d\n", per_cu); per_cu = 1; (void)hipGetLastError(); }
        grid = cus * 1;
    }
    if (grid < 0) return;
    Params p{};
    for (int i = 0; i < 29; ++i) p.in[i] = (const float*)d_in[i];
    p.out = (float*)d_out; p.ws = (unsigned char*)d_ws;
#if MK_COOP
    p.lo = 0; p.hi = NSTEPS;
    void* args[] = {&p};
    hipError_t e = hipLaunchCooperativeKernel((const void*)mk_fwd, dim3(grid), dim3(512), args, LDS_BYTES, stream);
    if (e != hipSuccess) fprintf(stderr, "cooperative launch failed: %s (grid %d)\n", hipGetErrorString(e), grid);
#else
    for (int s = 0; s < NSTEPS; ++s) { p.lo = s; p.hi = s + 1; hipLaunchKernelGGL(mk_fwd, dim3(grid), dim3(512), LDS_BYTES, stream, p); }
#endif
}
#ifdef RES_TEST
#define TK(name, body) __global__ void __launch_bounds__(512, 2) name(Params p) { extern __shared__ __attribute__((aligned(16))) unsigned char shm[]; LAS unsigned char* lds = (LAS unsigned char*)shm; body }
TK(t_step0, run_step((CParams)__builtin_amdgcn_kernarg_segment_ptr(), 0, lds);)
TK(t_ph0, run_step((CParams)__builtin_amdgcn_kernarg_segment_ptr(), 1 + 0, lds);)
TK(t_ph1, run_step((CParams)__builtin_amdgcn_kernarg_segment_ptr(), 1 + 1, lds);)
TK(t_ph2, run_step((CParams)__builtin_amdgcn_kernarg_segment_ptr(), 1 + 2, lds);)
TK(t_ph3, run_step((CParams)__builtin_amdgcn_kernarg_segment_ptr(), 1 + 3, lds);)
TK(t_ph4, run_step((CParams)__builtin_amdgcn_kernarg_segment_ptr(), 1 + 4, lds);)
TK(t_ph5, run_step((CParams)__builtin_amdgcn_kernarg_segment_ptr(), 1 + 5, lds);)
TK(t_ph6, run_step((CParams)__builtin_amdgcn_kernarg_segment_ptr(), 1 + 6, lds);)
TK(t_ph8, run_step((CParams)__builtin_amdgcn_kernarg_segment_ptr(), 1 + 8, lds);)
TK(t_ph11, run_step((CParams)__builtin_amdgcn_kernarg_segment_ptr(), 1 + 11, lds);)
TK(t_hg0, hgrn_item<0>(lds, (const bf16_t*)p.ws, (const bf16_t*)p.ws, p.lo, p.hi, 1, p.in[5], (bf16_t*)p.out);)
TK(t_hg1, hgrn_item<1>(lds, (const bf16_t*)p.ws, (const bf16_t*)p.ws, p.lo, p.hi, 1, p.in[5], (bf16_t*)p.out);)
TK(t_at, (attn_unit<4, true>(lds, (const bf16_t*)p.ws, NPROJ, (const bf16_t*)p.ws, NPROJ, (const bf16_t*)p.ws, (size_t)GR, p.hi, p.lo, p.in[4], 0.3f, p.in[13], (bf16_t*)p.out, 1024, 0.18f));)
TK(t_xat, (attn_unit<8, false>(lds, (const bf16_t*)p.ws, NPROJ, (const bf16_t*)p.ws, NPROJ, (const bf16_t*)p.ws, (size_t)GR, p.hi, p.lo, p.in[4], 0.3f, p.in[13], (bf16_t*)p.out, 1024, 0.18f));)
#endif
```
